# Optimizing an MI355X kernel written in HIP

```python
import math
import jax
import jax.numpy as jnp
from jax import lax
import numpy as np

D_MODEL = 1024
BATCH = 16
SEQ = 4096
DEPTH = 1

D_MIX = D_MODEL
SSD_WIDTH = D_MIX // 2
SSD_HEADDIM = 64
SSD_HEADS = SSD_WIDTH // SSD_HEADDIM
SSD_NGROUPS = 2
SSD_HPG = SSD_HEADS // SSD_NGROUPS
SSD_DSTATE = 128
SSD_CONV = 5
SSD_CHUNK = 128
SSD_CONV_CH = SSD_WIDTH + 2 * SSD_NGROUPS * SSD_DSTATE
DA_WIDTH = D_MIX - SSD_WIDTH
DA_HEADDIM = 64
DA_VDIM = 2 * DA_HEADDIM
DA_HEADS = DA_WIDTH // DA_VDIM
Q_BLOCK = 128
COL_Z = SSD_WIDTH
COL_XBC = SSD_CONV_CH
COL_DT = 2 * SSD_HEADS
COL_Q = DA_HEADS * 2 * DA_HEADDIM
COL_K = DA_HEADS * 2 * DA_HEADDIM
COL_V = DA_HEADS * DA_VDIM
D_IN_PROJ = COL_Z + COL_XBC + COL_DT + COL_Q + COL_K + COL_V
N_EXPERT_GROUPS = 4
EXPERTS_PER_GROUP = 8
N_EXPERTS = N_EXPERT_GROUPS * EXPERTS_PER_GROUP
TOP_K = 2
D_EXPERT = 512
MOE_BLOCK = 128
EPS = 1e-6

kernel_name = 'hymba_ssd_diffattn_hmoe_encoder'


def rmsnorm(x, w):
    xf = x.astype(jnp.float32)
    y = xf * lax.rsqrt(jnp.mean(xf * xf, axis=-1, keepdims=True) + EPS)
    return (y * w.astype(jnp.float32)).astype(x.dtype)


def centred_depthwise_conv(u, w, b):
    pad = (SSD_CONV - 1) // 2
    out = lax.conv_general_dilated(
        u, w[:, None, :].astype(u.dtype), window_strides=(1,), padding=[(pad, pad)],
        dimension_numbers=('NWC', 'WIO', 'NWC'), feature_group_count=u.shape[-1])
    return out + b.astype(u.dtype)


def ssd_scan(x, dt, a, bm, cm):
    bsz, L, G, R, P = x.shape
    N = bm.shape[-1]
    Q = SSD_CHUNK
    nc = L // Q
    xdt = (x * dt[..., None]).reshape(bsz, nc, Q, G, R, P)
    a_dt = (dt * a).reshape(bsz, nc, Q, G, R).transpose(0, 3, 4, 1, 2)
    bm = bm.reshape(bsz, nc, Q, G, N)
    cm = cm.reshape(bsz, nc, Q, G, N)
    a_cs = jnp.cumsum(a_dt, axis=-1)
    lower = jnp.tril(jnp.ones((Q, Q), dtype=bool))
    seg = a_cs[..., :, None] - a_cs[..., None, :]
    decay_in = jnp.exp(jnp.where(lower, seg, -jnp.inf))
    cb = jnp.einsum('bclgn,bcsgn->bcgls', cm, bm)
    y_diag = jnp.einsum('bcgls,bgrcls,bcsgrp->bclgrp', cb, decay_in, xdt)
    decay_to_end = jnp.exp(a_cs[..., -1:] - a_cs)
    chunk_states = jnp.einsum('bcsgn,bgrcs,bcsgrp->bcgrpn', bm, decay_to_end, xdt)
    chunk_decay = jnp.exp(a_cs[..., -1])

    def step(h, inp):
        s, d = inp
        return d[..., None, None] * h + s, h

    h0 = jnp.zeros((bsz, G, R, P, N), dtype=xdt.dtype)
    _, h_prev = lax.scan(step, h0, (jnp.moveaxis(chunk_states, 1, 0),
                                    jnp.moveaxis(chunk_decay, -1, 0)))
    h_prev = jnp.moveaxis(h_prev, 0, 1)
    y_off = jnp.einsum('bclgn,bgrcl,bcgrpn->bclgrp', cm, jnp.exp(a_cs), h_prev)
    return (y_diag + y_off).reshape(bsz, L, G, R, P)


def ssd_mixer(z, xbc, dt_raw, conv_w, conv_b, dt_bias_f, dt_bias_b, a_log_f, a_log_b,
              d_skip, norm_w):
    bsz, L = z.shape[:2]
    G, R, P, N, H = SSD_NGROUPS, SSD_HPG, SSD_HEADDIM, SSD_DSTATE, SSD_HEADS
    xbc = jax.nn.silu(centred_depthwise_conv(xbc, conv_w, conv_b)).astype(jnp.float32)
    xs = xbc[..., :SSD_WIDTH].reshape(bsz, L, G, R, P)
    bm = xbc[..., SSD_WIDTH:SSD_WIDTH + G * N].reshape(bsz, L, G, N)
    cm = xbc[..., SSD_WIDTH + G * N:].reshape(bsz, L, G, N)
    dt_raw = dt_raw.astype(jnp.float32)
    dt_f = jax.nn.softplus(dt_raw[..., :H] + dt_bias_f).reshape(bsz, L, G, R)
    dt_b = jax.nn.softplus(dt_raw[..., H:] + dt_bias_b).reshape(bsz, L, G, R)
    a_f = -jnp.exp(a_log_f.astype(jnp.float32)).reshape(G, R)
    a_b = -jnp.exp(a_log_b.astype(jnp.float32)).reshape(G, R)
    flip = lambda t: jnp.flip(t, axis=1)
    y_f = ssd_scan(xs, dt_f, a_f, bm, cm)
    y_b = flip(ssd_scan(flip(xs), flip(dt_b), a_b, flip(bm), flip(cm)))
    y = y_f + y_b + d_skip.astype(jnp.float32).reshape(G, R)[:, :, None] * xs
    y = y.reshape(bsz, L, SSD_WIDTH)
    gated = y * jax.nn.silu(z.astype(jnp.float32))
    return rmsnorm(gated, norm_w).astype(z.dtype)


def diff_attention(q, k, v, lq1, lk1, lq2, lk2, subln_w, lambda_init):
    bsz, L = q.shape[:2]
    H, D, V = DA_HEADS, DA_HEADDIM, DA_VDIM
    out_dtype = q.dtype
    q = q.reshape(bsz, L, H, 2, D).transpose(0, 2, 3, 1, 4).astype(jnp.float32) * (D ** -0.5)
    k = k.reshape(bsz, L, H, 2, D).transpose(0, 2, 3, 1, 4).astype(jnp.float32)
    v = v.reshape(bsz, L, H, V).transpose(0, 2, 1, 3).astype(jnp.float32)
    lam = (jnp.exp(jnp.sum(lq1.astype(jnp.float32) * lk1.astype(jnp.float32)))
           - jnp.exp(jnp.sum(lq2.astype(jnp.float32) * lk2.astype(jnp.float32)))
           + lambda_init)
    slopes = jnp.power(2.0, -8.0 * jnp.arange(1, H + 1, dtype=jnp.float32) / H)
    nq = L // Q_BLOCK
    q_blocks = jnp.moveaxis(q.reshape(bsz, H, 2, nq, Q_BLOCK, D), 3, 0)
    k_pos = jnp.arange(L, dtype=jnp.float32)

    def attend(args):
        qb, blk = args
        q_pos = (blk * Q_BLOCK).astype(jnp.float32) + jnp.arange(Q_BLOCK, dtype=jnp.float32)
        dist = jnp.abs(q_pos[:, None] - k_pos[None, :])
        s = jnp.einsum('bhcqd,bhckd->bhcqk', qb, k) - slopes[:, None, None, None] * dist
        p = jax.nn.softmax(s, axis=-1)
        w = p[:, :, 0] - lam * p[:, :, 1]
        return jnp.einsum('bhqk,bhkv->bhqv', w, v)

    o = lax.map(attend, (q_blocks, jnp.arange(nq, dtype=jnp.int32)))
    o = o.transpose(1, 0, 3, 2, 4).reshape(bsz, L, H, V)
    o = rmsnorm(o, subln_w) * (1.0 - lambda_init)
    return o.reshape(bsz, L, H * V).astype(out_dtype)


def hier_moe(u, w_rg, b_rg, w_re, b_re, w_gate, w_up, w_down):
    bsz, L, d = u.shape
    T = bsz * L
    xt = u.reshape(T, d)
    g_logits = jnp.einsum('td,dg->tg', xt, w_rg).astype(jnp.float32) + b_rg
    p_group = jax.nn.softmax(g_logits, axis=-1)
    g_idx = jnp.argmax(g_logits, axis=-1).astype(jnp.int32)
    p_g = jnp.take_along_axis(p_group, g_idx[:, None], axis=1)
    e_logits = (jnp.einsum('td,de->te', xt, w_re).astype(jnp.float32) + b_re)
    e_logits = e_logits.reshape(T, N_EXPERT_GROUPS, EXPERTS_PER_GROUP)
    sel = jnp.take_along_axis(e_logits, g_idx[:, None, None], axis=1)[:, 0]
    top_p, top_i = lax.top_k(jax.nn.softmax(sel, axis=-1), TOP_K)
    top_p = top_p / jnp.sum(top_p, axis=-1, keepdims=True)
    gates = (p_g * top_p).reshape(-1)
    eid = (g_idx[:, None] * EXPERTS_PER_GROUP + top_i).reshape(-1).astype(jnp.int32)
    tok = jnp.repeat(jnp.arange(T, dtype=jnp.int32), TOP_K)
    n_assign = T * TOP_K
    order = jnp.argsort(eid)
    e_s, tok_s, gate_s = eid[order], tok[order], gates[order]
    counts = jnp.bincount(eid, length=N_EXPERTS).astype(jnp.int32)
    starts = jnp.cumsum(counts) - counts
    padded = (counts + MOE_BLOCK - 1) // MOE_BLOCK * MOE_BLOCK
    p_ends = jnp.cumsum(padded)
    p_starts = p_ends - padded
    slot = p_starts[e_s] + jnp.arange(n_assign, dtype=jnp.int32) - starts[e_s]
    n_blocks = (n_assign + MOE_BLOCK - 1) // MOE_BLOCK + N_EXPERTS
    n_slots = n_blocks * MOE_BLOCK
    slot_tok = jnp.zeros((n_slots,), jnp.int32).at[slot].set(tok_s)
    slot_gate = jnp.zeros((n_slots,), jnp.float32).at[slot].set(gate_s)
    block_start = jnp.arange(n_blocks, dtype=jnp.int32) * MOE_BLOCK
    block_e = jnp.minimum(jnp.searchsorted(p_ends, block_start, side='right'),
                          N_EXPERTS - 1).astype(jnp.int32)

    def run_block(args):
        toks, g, e = args
        xb = xt[toks]
        hdn = jax.nn.silu(xb @ w_gate[e]) * (xb @ w_up[e])
        return (hdn @ w_down[e]) * g[:, None].astype(xb.dtype)

    y = lax.map(run_block, (slot_tok.reshape(n_blocks, MOE_BLOCK),
                            slot_gate.reshape(n_blocks, MOE_BLOCK), block_e))
    y = jax.ops.segment_sum(y.reshape(n_slots, d), slot_tok, num_segments=T)
    return y.reshape(bsz, L, d).astype(u.dtype)


def setup_inputs(seed: int = 0) -> dict:
    key = jax.random.key(seed)
    ks = jax.random.split(key, 32)
    f32 = jnp.float32

    def nrm(k, shape, scale):
        return jax.random.normal(k, shape, f32) * scale

    def gain(k, shape):
        return 1.0 + 0.02 * jax.random.normal(k, shape, f32)

    def dt_bias(k):
        u = jax.random.uniform(k, (DEPTH, SSD_HEADS), f32)
        dt = jnp.exp(u * (math.log(0.1) - math.log(0.001)) + math.log(0.001))
        return dt + jnp.log(-jnp.expm1(-dt))

    def a_log(k):
        return jnp.log(jax.random.uniform(k, (DEPTH, SSD_HEADS), f32, minval=1.0, maxval=16.0))

    return {
        'x': jax.random.normal(ks[0], (BATCH, SEQ, D_MODEL), f32),
        'norm_mix_w': gain(ks[1], (DEPTH, D_MODEL)),
        'w_in': nrm(ks[2], (DEPTH, D_MODEL, D_IN_PROJ), D_MODEL ** -0.5),
        'conv_w': nrm(ks[3], (DEPTH, SSD_CONV, SSD_CONV_CH), SSD_CONV ** -0.5),
        'conv_b': nrm(ks[4], (DEPTH, SSD_CONV_CH), 0.02),
        'dt_bias_fwd': dt_bias(ks[5]),
        'dt_bias_bwd': dt_bias(ks[6]),
        'a_log_fwd': a_log(ks[7]),
        'a_log_bwd': a_log(ks[8]),
        'ssd_d': 1.0 + 0.1 * jax.random.normal(ks[9], (DEPTH, SSD_HEADS), f32),
        'ssd_norm_w': gain(ks[10], (DEPTH, SSD_WIDTH)),
        'lambda_q1': nrm(ks[11], (DEPTH, DA_HEADDIM), 0.1),
        'lambda_k1': nrm(ks[12], (DEPTH, DA_HEADDIM), 0.1),
        'lambda_q2': nrm(ks[13], (DEPTH, DA_HEADDIM), 0.1),
        'lambda_k2': nrm(ks[14], (DEPTH, DA_HEADDIM), 0.1),
        'subln_w': gain(ks[15], (DEPTH, DA_VDIM)),
        'w_out': nrm(ks[16], (DEPTH, D_MIX, D_MODEL), D_MIX ** -0.5),
        'norm_ffn_w': gain(ks[17], (DEPTH, D_MODEL)),
        'w_router_group': nrm(ks[18], (DEPTH, D_MODEL, N_EXPERT_GROUPS), D_MODEL ** -0.5),
        'b_router_group': nrm(ks[19], (DEPTH, N_EXPERT_GROUPS), 0.01),
        'w_router_exp': nrm(ks[20], (DEPTH, D_MODEL, N_EXPERTS), D_MODEL ** -0.5),
        'b_router_exp': nrm(ks[21], (DEPTH, N_EXPERTS), 0.01),
        'w_exp_gate': nrm(ks[22], (DEPTH, N_EXPERTS, D_MODEL, D_EXPERT), D_MODEL ** -0.5),
        'w_exp_up': nrm(ks[23], (DEPTH, N_EXPERTS, D_MODEL, D_EXPERT), D_MODEL ** -0.5),
        'w_exp_down': nrm(ks[24], (DEPTH, N_EXPERTS, D_EXPERT, D_MODEL), D_EXPERT ** -0.5),
        'norm_final_w': gain(ks[25], (D_MODEL,)),
    }


def reference(x, norm_mix_w, w_in, conv_w, conv_b, dt_bias_fwd, dt_bias_bwd, a_log_fwd,
              a_log_bwd, ssd_d, ssd_norm_w, lambda_q1, lambda_k1, lambda_q2, lambda_k2,
              subln_w, w_out, norm_ffn_w, w_router_group, b_router_group, w_router_exp,
              b_router_exp, w_exp_gate, w_exp_up, w_exp_down, norm_final_w):
    splits = [int(s) for s in np.cumsum([COL_Z, COL_XBC, COL_DT, COL_Q, COL_K])]
    h = x
    for l in range(DEPTH):
        lambda_init = 0.8 - 0.6 * math.exp(-0.3 * l)
        u = rmsnorm(h, norm_mix_w[l])
        proj = jnp.einsum('bsd,de->bse', u, w_in[l])
        z, xbc, dt_raw, q, k, v = jnp.split(proj, splits, axis=-1)
        y_ssd = ssd_mixer(z, xbc, dt_raw, conv_w[l], conv_b[l], dt_bias_fwd[l], dt_bias_bwd[l],
                          a_log_fwd[l], a_log_bwd[l], ssd_d[l], ssd_norm_w[l])
        y_da = diff_attention(q, k, v, lambda_q1[l], lambda_k1[l], lambda_q2[l], lambda_k2[l],
                              subln_w[l], lambda_init)
        mix = jnp.concatenate([y_ssd.astype(h.dtype), y_da.astype(h.dtype)], axis=-1)
        h = h + jnp.einsum('bse,ed->bsd', mix, w_out[l])
        h = h + hier_moe(rmsnorm(h, norm_ffn_w[l]), w_router_group[l], b_router_group[l],
                         w_router_exp[l], b_router_exp[l], w_exp_gate[l], w_exp_up[l],
                         w_exp_down[l])
    return rmsnorm(h, norm_final_w)
```

```cpp
#include <hip/hip_runtime.h>
#include <hip/hip_cooperative_groups.h>
#include <cstdio>
#include <cstdint>
namespace cg = cooperative_groups;


#define LAS __attribute__((address_space(3)))
#define DEV __device__ __forceinline__
typedef unsigned short bf16_t;
typedef short bf16x8 __attribute__((ext_vector_type(8)));
typedef float f32x4 __attribute__((ext_vector_type(4)));
typedef float f32x16 __attribute__((ext_vector_type(16)));
typedef unsigned u32x4 __attribute__((ext_vector_type(4)));
typedef unsigned u32x2 __attribute__((ext_vector_type(2)));

constexpr int NTOK = 65536, DM = 1024, SEQ = 4096, NBATCH = 16, NCHUNK = 32;
constexpr float EPS = 1e-6f;
constexpr float LOG2E = 1.4426950408889634f;
constexpr float QSCALE = 0.125f * 1.4426950408889634f;
constexpr float LAMBDA_INIT = 0.2f;

constexpr size_t MiB = 1ull << 20;
constexpr size_t WS_CTL = 0, CTL_ZERO_BYTES = 32768;
constexpr size_t WS_LTOK = 1 * MiB, WS_LGATE = 9 * MiB, WS_LRL = 17 * MiB, WS_TOKEP = 25 * MiB, WS_CD = 26 * MiB, WS_RSS = 27 * MiB, WS_WR = 31 * MiB;
constexpr size_t WS_WIN = 32 * MiB, WS_WOUT = 40 * MiB, WS_WGU = 48 * MiB, WS_WD = 112 * MiB;
constexpr size_t WS_U = 144 * MiB, WS_XBC = 272 * MiB, WS_Z = 400 * MiB, WS_Q = 464 * MiB, WS_K = 528 * MiB, WS_VT = 592 * MiB, WS_DT = 656 * MiB, WS_ST = 664 * MiB, WS_MIX = 792 * MiB;
constexpr size_t WS_XCX = 176 * MiB, WS_XCBC = 920 * MiB;
constexpr size_t WS_DTT = 240 * MiB;
constexpr size_t WS_RLS = 31 * MiB + 512 * 1024;
constexpr size_t WS_H = 464 * MiB, WS_HDN = 272 * MiB, WS_Y = 592 * MiB, WS_LOG = 144 * MiB, WS_END = 984 * MiB;

constexpr int LDS_BYTES = 163840;
constexpr int LDS_MISC = 131072;

struct Params {
    const float* x; const float* norm_mix_w; const float* w_in; const float* conv_w; const float* conv_b;
    const float* dt_bias_f; const float* dt_bias_b; const float* a_log_f; const float* a_log_b; const float* ssd_d; const float* ssd_norm_w;
    const float* lq1; const float* lk1; const float* lq2; const float* lk2; const float* subln_w; const float* w_out; const float* norm_ffn_w;
    const float* w_rg; const float* b_rg; const float* w_re; const float* b_re; const float* w_gate; const float* w_up; const float* w_down; const float* norm_final_w;
    float* out; unsigned char* ws;
};

typedef float f32x2_t __attribute__((ext_vector_type(2)));
typedef __bf16 bf16x2_t __attribute__((ext_vector_type(2)));
DEV unsigned pk_bf16(float lo, float hi) { const f32x2_t v = {lo, hi}; const bf16x2_t b = __builtin_convertvector(v, bf16x2_t); return __builtin_bit_cast(unsigned, b); }
DEV float bflo(unsigned u) { return __uint_as_float(u << 16); }
DEV float bfhi(unsigned u) { return __uint_as_float(u & 0xffff0000u); }
template <int O> DEV float xor_other(float v) {
    return __int_as_float(__builtin_amdgcn_ds_swizzle(__float_as_int(v), (O << 10) | 0x1f)); }
DEV float sum_xor32(float v) { const auto rr = __builtin_amdgcn_permlane32_swap(__float_as_uint(v), __float_as_uint(v), false, false); return __uint_as_float(rr[0]) + __uint_as_float(rr[1]); }
DEV float wave_sum(float v) {
    v += xor_other<1>(v); v += xor_other<2>(v); v += xor_other<4>(v); v += xor_other<8>(v); v += xor_other<16>(v);
    return sum_xor32(v);
}
DEV float fast_exp2(float v) { return __builtin_amdgcn_exp2f(v); }
DEV float fadd_s(float a, float b) { float r; asm volatile("v_add_f32_e32 %0, %1, %2" : "=v"(r) : "v"(a), "v"(b)); return r; }
DEV float ffma_sk(float k, float a, float b) { float r; asm("v_fma_f32 %0, %1, %2, %3" : "=v"(r) : "s"(k), "v"(a), "v"(b)); return r; }
DEV float fast_rcp(float v) { return __builtin_amdgcn_rcpf(v); }
DEV float silu_f(float v) { return v * fast_rcp(1.f + fast_exp2(-v * LOG2E)); }
#define LDS_WAIT() asm volatile("s_waitcnt lgkmcnt(0)" ::: "memory")
constexpr int LDS_WTAB = LDS_BYTES - 16 - 256;
DEV int hw_wave_slot() { return (int)__builtin_amdgcn_s_getreg((5 << 11) | 4) & 63; }
DEV int opaque_tid() {
    extern __shared__ __attribute__((aligned(16))) unsigned char lds_raw[];
    const int wave = __builtin_amdgcn_readfirstlane(*(const LAS int*)((LAS unsigned char*)lds_raw + LDS_WTAB + 4 * hw_wave_slot()));
    int t = wave * 64 + (int)__builtin_amdgcn_mbcnt_hi(~0u, __builtin_amdgcn_mbcnt_lo(~0u, 0u));
    asm volatile("" : "+v"(t)); return t; }

struct P0Item { const float* colptr; size_t ldn; const float* kscale; bf16_t* dst; int k0, Kd, n0, nt; };
DEV void p0_load(const P0Item& I, float (&v)[32], f32x4 (&sc)[2], int lane) {
#pragma unroll
    for (int i = 0; i < 32; ++i) { const int kk = 2 * i + (lane >> 5); v[i] = I.colptr ? I.colptr[(size_t)(I.k0 + kk) * I.ldn] : 0.f; }
    const int c = lane & 7;
    if (I.kscale) { sc[0] = *(const f32x4*)(I.kscale + I.k0 + 8 * c); sc[1] = *(const f32x4*)(I.kscale + I.k0 + 8 * c + 4); }
    else { sc[0] = (f32x4){1.f, 1.f, 1.f, 1.f}; sc[1] = sc[0]; }
}
DEV void p0_emit(const P0Item& I, const float (&v)[32], const f32x4 (&sc)[2], LAS float* scr, int lane) {
#pragma unroll
    for (int i = 0; i < 32; ++i) { const int kk = 2 * i + (lane >> 5); scr[kk * 33 + (lane & 31)] = v[i]; }
    LDS_WAIT();
    const int c = lane & 7;
#pragma unroll
    for (int j = 0; j < 4; ++j) {
        const int n = (lane >> 3) + 8 * j; const LAS float* s = scr + (8 * c) * 33 + n;
        u32x4 o; o.x = pk_bf16(s[0 * 33] * sc[0][0], s[1 * 33] * sc[0][1]); o.y = pk_bf16(s[2 * 33] * sc[0][2], s[3 * 33] * sc[0][3]);
        o.z = pk_bf16(s[4 * 33] * sc[1][0], s[5 * 33] * sc[1][1]); o.w = pk_bf16(s[6 * 33] * sc[1][2], s[7 * 33] * sc[1][3]);
        u32x4* op_ = (u32x4*)(I.dst + (size_t)(I.n0 + n) * I.Kd + I.k0 + 8 * c);
        if (I.nt) __builtin_nontemporal_store(o, op_); else *op_ = o;
    }
    LDS_WAIT();
}
DEV P0Item p0_decode(const Params& P, int it, int l31) {
    bf16_t* WIN = (bf16_t*)(P.ws + WS_WIN); bf16_t* WOUT = (bf16_t*)(P.ws + WS_WOUT); bf16_t* WGU = (bf16_t*)(P.ws + WS_WGU); bf16_t* WD = (bf16_t*)(P.ws + WS_WD); bf16_t* WR = (bf16_t*)(P.ws + WS_WR);
    constexpr int I_IN = 16 * 104, I_OUT = 16 * 32, I_GU = 32 * 512, I_D = 32 * 256;
    P0Item I;
    if (it < I_IN) {
        const int kb = it / 104, nb = it % 104, np = 32 * nb + l31;
        const int col = np < 1536 ? np : (np < 3072 ? np + 16 : (np < 3088 ? np - 1536 : -1));
        I.colptr = col >= 0 ? P.w_in + col : nullptr; I.ldn = 3088; I.k0 = 64 * kb; I.kscale = nullptr; I.dst = WIN; I.Kd = 1024; I.n0 = 32 * nb; I.nt = 0; return I; }
    it -= I_IN;
    if (it < I_OUT) { const int kb = it / 32, nb = it % 32; I.colptr = P.w_out + 32 * nb + l31; I.ldn = 1024; I.k0 = 64 * kb; I.kscale = nullptr; I.dst = WOUT; I.Kd = 1024; I.n0 = 32 * nb; I.nt = 1; return I; }
    it -= I_OUT;
    if (it < I_GU) {
        const int e = it / 512, r = it % 512, kb = r / 32, nb = r % 32, np = 32 * nb + l31, bj = (np >> 7) & 1, col = 128 * (np >> 8) + (np & 127);
        I.colptr = (bj ? P.w_up : P.w_gate) + (size_t)e * 1024 * 512 + col; I.ldn = 512; I.k0 = 64 * kb; I.kscale = P.norm_ffn_w; I.dst = WGU + (size_t)e * 1024 * 1024; I.Kd = 1024; I.n0 = 32 * nb; I.nt = 1; return I; }
    it -= I_GU;
    if (it < I_D) { const int e = it / 256, r = it % 256, kb = r / 32, nb = r % 32;
        const int csrc = (nb >> 3) * 256 + 64 * (nb & 3) + 32 * ((nb >> 2) & 1);
        I.colptr = P.w_down + (size_t)e * 512 * 1024 + csrc + l31; I.ldn = 1024; I.k0 = 64 * kb; I.kscale = nullptr; I.dst = WD + (size_t)e * 1024 * 512; I.Kd = 512; I.n0 = 32 * nb; I.nt = 1; return I; }
    it -= I_D;
    { const int kb = it / 8, nb = it % 8, np = 32 * nb + l31;
      I.colptr = np < 4 ? P.w_rg + np : (np < 36 ? P.w_re + (np - 4) : nullptr); I.ldn = np < 4 ? 4 : 32; I.k0 = 64 * kb; I.kscale = P.norm_ffn_w; I.dst = WR; I.Kd = 1024; I.n0 = 32 * nb; I.nt = 1; return I; }
}

DEV void p0_phase(const Params& P, LAS unsigned char* lds) {
    const int tid = opaque_tid(), lane = tid & 63, wave = tid >> 6;
    LAS float* scr = (LAS float*)(lds + wave * 16384);
    const int gw = blockIdx.x * 8 + wave, NGW = gridDim.x * 8;
    constexpr int NITEMS = 16 * 104 + 16 * 32 + 32 * 512 + 32 * 256 + 16 * 8;
    {
        const int l31 = lane & 31;
        float va[32], vb[32]; f32x4 sa[2], sb[2]; P0Item cur, nxt;
        int it = gw;
        if (it < NITEMS) { cur = p0_decode(P, it, l31); p0_load(cur, va, sa, lane); }
        while (it < NITEMS) {
            int itn = it + NGW;
            if (itn < NITEMS) { nxt = p0_decode(P, itn, l31); p0_load(nxt, vb, sb, lane); }
            p0_emit(cur, va, sa, scr, lane);
            it = itn; if (it >= NITEMS) break;
            itn = it + NGW;
            if (itn < NITEMS) { cur = p0_decode(P, itn, l31); p0_load(cur, va, sa, lane); }
            p0_emit(nxt, vb, sb, scr, lane);
            it = itn;
        }
    }
    bf16_t* U = (bf16_t*)(P.ws + WS_U);
    f32x4 wv[4];
#pragma unroll
    for (int j = 0; j < 4; ++j) wv[j] = ((const f32x4*)P.norm_mix_w)[lane + 64 * j];
#define P0_XLOAD(v, m) do { _Pragma("unroll") for (int q = 0; q < 2; ++q) { const f32x4* xr = (const f32x4*)(P.x + (size_t)((m) + q) * DM) + lane; \
        _Pragma("unroll") for (int j = 0; j < 4; ++j) v[q][j] = __builtin_nontemporal_load(xr + 64 * j); } } while (0)
#define P0_XEMIT(v, m) do { _Pragma("unroll") for (int q = 0; q < 2; ++q) { float ss = 0.f; \
        _Pragma("unroll") for (int j = 0; j < 4; ++j) ss += (v[q][j].x * v[q][j].x + v[q][j].y * v[q][j].y) + (v[q][j].z * v[q][j].z + v[q][j].w * v[q][j].w); \
        const float r = rsqrtf(wave_sum(ss) * (1.f / DM) + EPS); \
        u32x2* o = (u32x2*)(U + (size_t)((m) + q) * DM) + lane; \
        _Pragma("unroll") for (int j = 0; j < 4; ++j) { u32x2 w; w.x = pk_bf16(v[q][j].x * r * wv[j].x, v[q][j].y * r * wv[j].y); w.y = pk_bf16(v[q][j].z * r * wv[j].z, v[q][j].w * r * wv[j].w); o[64 * j] = w; } } } while (0)
    {
        f32x4 xa[2][4], xb[2][4];
        int m0 = 2 * gw; const int step = 2 * NGW;
        if (m0 < NTOK) P0_XLOAD(xa, m0);
        while (m0 < NTOK) {
            int m1 = m0 + step;
            if (m1 < NTOK) P0_XLOAD(xb, m1);
            P0_XEMIT(xa, m0);
            m0 = m1; if (m0 >= NTOK) break;
            m1 = m0 + step;
            if (m1 < NTOK) P0_XLOAD(xa, m1);
            P0_XEMIT(xb, m0);
            m0 = m1;
        }
    }
#undef P0_XLOAD
#undef P0_XEMIT
}

namespace g8 {
constexpr int HTB = 128 * 64 * 2;
DEV int lds_byte(int r, int c) { const int st = (r >> 4) * 2 + (c >> 5), rr = r & 15, cc = c & 31, ob = rr * 64 + cc * 2; return st * 1024 + (ob ^ (((ob >> 9) & 1) << 5)); }
DEV void stage_rc(int b, int& R, int& C) { const int st = b / 1024, sb = b % 1024, swz = sb ^ (((sb >> 9) & 1) << 5); R = (st >> 1) * 16 + swz / 64; C = (st & 1) * 32 + (swz % 64) / 2; }
DEV int perm32(int rho) { const int n = rho >> 4, i = rho & 15; return 8 * (i >> 2) + 4 * n + (i & 3); }

struct GUnit { const char* a; const char* b; int pm, pn, e, kind, cnt, ps; };

template <class Epi, class Sched>
DEV void gemm_phase(LAS unsigned char* lds, const int K, const Sched& S, const Epi& E) {
    int tid_ = opaque_tid();
    const int tid = tid_, wid = __builtin_amdgcn_readfirstlane(tid >> 6), lane = tid & 63, wr = wid >> 2, wc = wid & 3, fr = lane & 15, fq = lane >> 4;
    const int nt = K / 64;
    int Rr[2], Cc[2]; unsigned voffB[2];
#pragma unroll
    for (int i = 0; i < 2; ++i) { stage_rc(tid * 16 + i * 8192, Rr[i], Cc[i]); const int Rb = (Rr[i] & ~31) + perm32(Rr[i] & 31); voffB[i] = (unsigned)(Rb * K + Cc[i]) * 2u; }
    const size_t kstep = 128; const size_t hstepB = (size_t)128 * K * 2;
    const unsigned ldsw = (unsigned)wid * 1024u;
    const int aoff = lds_byte(wr * 64 + fr, fq * 8), boff = lds_byte(wc * 32 + fr, fq * 8);
#define G8_SA(b, h) (((b) * 2 + (h)) * HTB)
#define G8_SB(b, h) ((4 + (b) * 2 + (h)) * HTB)
#define G8_STAGE(bufoff, gbase, voff) do { _Pragma("unroll") for (int _i = 0; _i < 2; ++_i) \
        __builtin_amdgcn_global_load_lds((const unsigned*)((const char*)(gbase) + (voff)[_i]), (LAS unsigned*)(lds + (bufoff) + ldsw + _i * 8192), 16, 0, 0); } while (0)
#define G8_LDA(dst, b, h) do { _Pragma("unroll") for (int m = 0; m < 4; ++m) _Pragma("unroll") for (int k = 0; k < 2; ++k) dst[m][k] = *(const LAS bf16x8*)(lds + G8_SA(b, h) + aoff + m * 2048 + k * 1024); } while (0)
#define G8_LDB(dst, b, h) do { _Pragma("unroll") for (int n = 0; n < 2; ++n) _Pragma("unroll") for (int k = 0; k < 2; ++k) dst[n][k] = *(const LAS bf16x8*)(lds + G8_SB(b, h) + boff + n * 2048 + k * 1024); } while (0)
#define G8_MMA(ai, bj, At, Bt) do { __builtin_amdgcn_s_setprio(1); _Pragma("unroll") for (int m = 0; m < 4; ++m) _Pragma("unroll") for (int n = 0; n < 2; ++n) _Pragma("unroll") for (int k = 0; k < 2; ++k) \
        acc[ai][bj][m][n] = __builtin_amdgcn_mfma_f32_16x16x32_bf16(Bt[n][k], At[m][k], acc[ai][bj][m][n], 0, 0, 0); __builtin_amdgcn_s_setprio(0); } while (0)
#define G8_WAIT_V(n) asm volatile("s_waitcnt vmcnt(" #n ")" ::: "memory")
#define G8_WAIT_L(n) asm volatile("s_waitcnt lgkmcnt(" #n ")" ::: "memory")
#define G8_BAR __builtin_amdgcn_s_barrier()
#define G8_SCHED __builtin_amdgcn_sched_barrier(0)
    GUnit cur, nxt; int ui = 0;
    if (!S.next(0, cur)) return;
    unsigned voA[2][2], nvoA[2][2];
    S.aoff(cur, Rr, Cc, voA);
    f32x4 acc[2][2][4][2];
#pragma unroll
    for (int a = 0; a < 2; ++a)
#pragma unroll
        for (int b = 0; b < 2; ++b)
#pragma unroll
            for (int m = 0; m < 4; ++m)
#pragma unroll
                for (int n = 0; n < 2; ++n) acc[a][b][m][n] = (f32x4){0.f, 0.f, 0.f, 0.f};
    bf16x8 At[4][2], B0[2][2], B1[2][2];
    const char* cA = cur.a; const char* cB = cur.b;
    G8_STAGE(G8_SB(0, 0), cB, voffB); G8_STAGE(G8_SB(0, 1), cB + hstepB, voffB); G8_STAGE(G8_SA(0, 0), cA, voA[0]); G8_STAGE(G8_SA(0, 1), cA, voA[1]);
    if (wr == 1) G8_BAR;
    G8_WAIT_V(2); G8_BAR;
    G8_STAGE(G8_SB(1, 0), cB + kstep, voffB); G8_STAGE(G8_SA(1, 0), cA + kstep, voA[0]); G8_STAGE(G8_SB(1, 1), cB + hstepB + kstep, voffB);
    G8_WAIT_V(6); G8_BAR;
    for (;;) {
        const bool has_next = S.next(ui + 1, nxt);
        const char* nA = has_next ? nxt.a : cA; const char* nB = has_next ? nxt.b : cB;
        if constexpr (Sched::GATHER) {
            if (has_next) S.aoff(nxt, Rr, Cc, nvoA);
            else {
#pragma unroll
                for (int h = 0; h < 2; ++h)
#pragma unroll
                    for (int i = 0; i < 2; ++i) nvoA[h][i] = voA[h][i];
            }
        }
        for (int t = 0; t < nt; t += 2) {
            S.mid(cur, t, acc, wr, fr);
            const bool last = (t == nt - 2);
            const char* a1 = cA + (size_t)(t + 1) * kstep;
            const char* a2 = last ? nA : cA + (size_t)(t + 2) * kstep; const char* b2 = last ? nB : cB + (size_t)(t + 2) * kstep;
            const char* a3 = a2 + kstep; const char* b3 = b2 + kstep;
            unsigned o2[2][2];
#pragma unroll
            for (int h = 0; h < 2; ++h)
#pragma unroll
                for (int i = 0; i < 2; ++i) { if constexpr (Sched::GATHER) o2[h][i] = last ? nvoA[h][i] : voA[h][i]; else o2[h][i] = voA[h][i]; }
            G8_LDB(B0, 0, 0); G8_LDB(B1, 0, 1); G8_SCHED; G8_LDA(At, 0, 0); G8_STAGE(G8_SA(1, 1), a1, voA[1]);
            G8_WAIT_V(8); G8_WAIT_L(0); G8_BAR; G8_MMA(0, 0, At, B0); G8_MMA(0, 1, At, B1); G8_BAR; G8_SCHED;
            G8_LDA(At, 0, 1); G8_STAGE(G8_SB(0, 0), b2, voffB); G8_STAGE(G8_SB(0, 1), b2 + hstepB, voffB); G8_STAGE(G8_SA(0, 0), a2, o2[0]);
            G8_WAIT_V(8); G8_WAIT_L(0); G8_BAR; G8_MMA(1, 0, At, B0); G8_MMA(1, 1, At, B1); G8_BAR; G8_SCHED;
            G8_LDB(B0, 1, 0); G8_LDB(B1, 1, 1); G8_SCHED; G8_LDA(At, 1, 0); G8_STAGE(G8_SA(0, 1), a2, o2[1]);
            G8_WAIT_V(8); G8_WAIT_L(0); G8_BAR; G8_MMA(0, 0, At, B0); G8_MMA(0, 1, At, B1); G8_BAR; G8_SCHED;
            G8_LDA(At, 1, 1); G8_STAGE(G8_SB(1, 0), b3, voffB); G8_STAGE(G8_SB(1, 1), b3 + hstepB, voffB); G8_STAGE(G8_SA(1, 0), a3, o2[0]);
            G8_WAIT_V(8); G8_WAIT_L(0); G8_BAR; G8_MMA(1, 0, At, B0); G8_MMA(1, 1, At, B1); G8_BAR; G8_SCHED;
        }
        if (wr == 0) G8_BAR;
        E(acc, cur, wr, wc, fr, fq);
        if (!has_next) break;
#pragma unroll
        for (int a = 0; a < 2; ++a)
#pragma unroll
            for (int b = 0; b < 2; ++b)
#pragma unroll
                for (int m = 0; m < 4; ++m)
#pragma unroll
                    for (int n = 0; n < 2; ++n) acc[a][b][m][n] = (f32x4){0.f, 0.f, 0.f, 0.f};
        cur = nxt; cA = nA; cB = nB; ++ui;
        if constexpr (Sched::GATHER) {
#pragma unroll
            for (int h = 0; h < 2; ++h)
#pragma unroll
                for (int i = 0; i < 2; ++i) voA[h][i] = nvoA[h][i];
        }
        if (wr == 1) G8_BAR;
    }
    G8_WAIT_V(0);
    G8_BAR;
#undef G8_SA
#undef G8_SB
#undef G8_STAGE
#undef G8_LDA
#undef G8_LDB
#undef G8_MMA
#undef G8_WAIT_V
#undef G8_WAIT_L
#undef G8_BAR
#undef G8_SCHED
}

DEV bool static_tile(int i, int G, int c, int nM, int nN, int& pm, int& pn) {
    const int nwg = nM * nN; const long L = (long)i * G + c; if (L >= nwg) return false;
    int wgid = (int)L; { const int q = nwg / 8, r = nwg % 8, xcd = wgid % 8, off = wgid / 8; wgid = (xcd < r ? xcd * (q + 1) : r * (q + 1) + (xcd - r) * q) + off; }
    const int nig = 8 * nN, gid = wgid / nig, fm = gid * 8, gsz = (nM - fm) < 8 ? (nM - fm) : 8;
    pm = fm + ((wgid % nig) % gsz); pn = (wgid % nig) / gsz; return true;
}
DEV void plain_aoff(const int* R, const int* C, int K, unsigned (&o)[2][2]) {
#pragma unroll
    for (int h = 0; h < 2; ++h)
#pragma unroll
        for (int i = 0; i < 2; ++i) o[h][i] = (unsigned)((R[i] + 128 * h) * K + C[i]) * 2u;
}

struct SchedInProj {
    static constexpr bool GATHER = false;
    const char* U; const char* W; int G, c;
    DEV bool next(int i, GUnit& u) const {
        int pm, pn; if (!static_tile(i, G, c, 256, 13, pm, pn)) return false;
        u.pm = pm; u.pn = pn; u.e = 0; u.cnt = 0; u.ps = 0;
        if (pn == 10 || pn == 11) { u.a = W + (size_t)(pn * 256) * 2048; u.b = U + (size_t)pm * 256 * 2048; u.kind = 1; }
        else { u.a = U + (size_t)pm * 256 * 2048; u.b = W + (size_t)(pn * 256) * 2048; u.kind = (pn == 12) ? 2 : 0; }
        return true;
    }
    DEV void aoff(const GUnit&, const int* R, const int* C, unsigned (&o)[2][2]) const { plain_aoff(R, C, 1024, o); }
    DEV void mid(const GUnit&, int, f32x4 (&)[2][2][4][2], int, int) const {}
};
struct EpiInProj {
    bf16_t *Z, *XBC, *Q, *Kb, *VT; float* DT;
    DEV void operator()(const f32x4 (&acc)[2][2][4][2], const GUnit& u, int wr, int wc, int fr, int fq) const {
        if (u.kind == 2) {
            if (wc == 0 && fq < 2) {
#pragma unroll
                for (int ai = 0; ai < 2; ++ai)
#pragma unroll
                    for (int m = 0; m < 4; ++m) { float* p = DT + (size_t)(u.pm * 256 + ai * 128 + wr * 64 + m * 16 + fr) * 16 + 8 * fq; *(f32x4*)p = acc[ai][0][m][0]; *(f32x4*)(p + 4) = acc[ai][0][m][1]; }
            }
            return;
        }
        bf16_t* base; size_t ldc; int rowbase, colt; float sc = 1.f;
        if (u.kind == 1) { base = VT; ldc = 65536; rowbase = (u.pn - 10) * 256; colt = u.pm * 256; }
        else {
            rowbase = u.pm * 256; const int pn = u.pn;
            if (pn < 2) { base = Z; ldc = 512; colt = pn * 256; }
            else if (pn < 6) { base = XBC; ldc = 1024; colt = (pn - 2) * 256; }
            else if (pn < 8) { base = Q; ldc = 512; colt = (pn - 6) * 256; sc = QSCALE; }
            else { base = Kb; ldc = 512; colt = (pn - 8) * 256; }
        }
        const int row0 = rowbase + wr * 64 + fr, col0 = colt + wc * 32 + 8 * fq;
        if (u.kind == 1) {
            const int colp = colt + wc * 32 + 16 * (fq >> 1) + 4 * (fq & 1);
#pragma unroll
            for (int ai = 0; ai < 2; ++ai)
#pragma unroll
                for (int m = 0; m < 4; ++m) { bf16_t* rowp = base + (size_t)(row0 + ai * 128 + m * 16) * ldc + colp;
#pragma unroll
                    for (int bj = 0; bj < 2; ++bj) { const f32x4 v0 = acc[ai][bj][m][0], v1 = acc[ai][bj][m][1];
                        u32x2 w0, w1; w0.x = pk_bf16(v0[0], v0[1]); w0.y = pk_bf16(v0[2], v0[3]); w1.x = pk_bf16(v1[0], v1[1]); w1.y = pk_bf16(v1[2], v1[3]);
                        *(u32x2*)(rowp + bj * 128) = w0; *(u32x2*)(rowp + bj * 128 + 8) = w1; } }
            return;
        }
#pragma unroll
        for (int ai = 0; ai < 2; ++ai)
#pragma unroll
            for (int m = 0; m < 4; ++m) { bf16_t* rowp = base + (size_t)(row0 + ai * 128 + m * 16) * ldc + col0;
#pragma unroll
                for (int bj = 0; bj < 2; ++bj) { const f32x4 v0 = acc[ai][bj][m][0] * sc, v1 = acc[ai][bj][m][1] * sc;
                    u32x4 w; w.x = pk_bf16(v0[0], v0[1]); w.y = pk_bf16(v0[2], v0[3]); w.z = pk_bf16(v1[0], v1[1]); w.w = pk_bf16(v1[2], v1[3]);
                    *(u32x4*)(rowp + bj * 128) = w; } }
    }
};

struct SchedOutProj {
    static constexpr bool GATHER = false;
    const char* A; const char* W; const float* RLS; int G, c;
    DEV bool next(int i, GUnit& u) const {
        int pm, pn; if (!static_tile(i, G, c, 256, 4, pm, pn)) return false;
        u.pm = pm; u.pn = pn; u.e = 0; u.kind = 0; u.cnt = 0; u.ps = 0; u.a = A + (size_t)pm * 256 * 2048; u.b = W + (size_t)pn * 256 * 2048; return true;
    }
    DEV void aoff(const GUnit&, const int* R, const int* C, unsigned (&o)[2][2]) const { plain_aoff(R, C, 1024, o); }
    DEV void mid(const GUnit& u, int t, f32x4 (&acc)[2][2][4][2], int wr, int fr) const {
        if (t != 8) return;
        int off = u.pm * 256 + wr * 64 + fr; asm volatile("" : "+v"(off));
        const float* rp = RLS + off;
        float rv[8];
#pragma unroll
        for (int i = 0; i < 8; ++i) rv[i] = rp[(i >> 2) * 128 + (i & 3) * 16];
#pragma unroll
        for (int ai = 0; ai < 2; ++ai)
#pragma unroll
            for (int m = 0; m < 4; ++m) {
#pragma unroll
                for (int bj = 0; bj < 2; ++bj)
#pragma unroll
                    for (int n = 0; n < 2; ++n) acc[ai][bj][m][n] = acc[ai][bj][m][n] * rv[ai * 4 + m]; }
    }
};
struct EpiOutProj {
    const float* X; bf16_t* H; float* RSS;
    DEV void operator()(const f32x4 (&acc)[2][2][4][2], const GUnit& u, int wr, int wc, int fr, int fq) const {
        const int row0 = u.pm * 256 + wr * 64 + fr, col0 = u.pn * 256 + wc * 32 + 8 * fq;
#pragma unroll
        for (int ai = 0; ai < 2; ++ai)
#pragma unroll
            for (int m = 0; m < 4; ++m) { __builtin_amdgcn_sched_barrier(0); const int row = row0 + ai * 128 + m * 16; float ss = 0.f;
#pragma unroll
                for (int bj = 0; bj < 2; ++bj) { const float* xp = X + (size_t)row * DM + col0 + bj * 128;
                    const f32x4 v0 = acc[ai][bj][m][0] + *(const f32x4*)xp, v1 = acc[ai][bj][m][1] + *(const f32x4*)(xp + 4);
                    ss += (v0[0] * v0[0] + v0[1] * v0[1]) + (v0[2] * v0[2] + v0[3] * v0[3]) + (v1[0] * v1[0] + v1[1] * v1[1]) + (v1[2] * v1[2] + v1[3] * v1[3]);
                    u32x4 w; w.x = pk_bf16(v0[0], v0[1]); w.y = pk_bf16(v0[2], v0[3]); w.z = pk_bf16(v1[0], v1[1]); w.w = pk_bf16(v1[2], v1[3]);
                    *(u32x4*)(H + (size_t)row * DM + col0 + bj * 128) = w; }
                ss += xor_other<16>(ss); ss = sum_xor32(ss);
                if (fq == 0) RSS[(size_t)row * 16 + u.pn * 4 + wc] = ss; }
    }
};

struct SchedRouter {
    static constexpr bool GATHER = false;
    const char* A; const char* W; int G, c;
    DEV bool next(int i, GUnit& u) const {
        const int L = i * G + c; if (L >= 256) return false;
        u.pm = L; u.pn = 0; u.e = 0; u.kind = 0; u.cnt = 0; u.ps = 0; u.a = A + (size_t)L * 256 * 2048; u.b = W; return true;
    }
    DEV void aoff(const GUnit&, const int* R, const int* C, unsigned (&o)[2][2]) const { plain_aoff(R, C, 1024, o); }
    DEV void mid(const GUnit&, int, f32x4 (&)[2][2][4][2], int, int) const {}
};
struct EpiRouter {
    float* LOG;
    DEV void operator()(const f32x4 (&acc)[2][2][4][2], const GUnit& u, int wr, int wc, int fr, int fq) const {
        if (wc >= 2) return;
#pragma unroll
        for (int ai = 0; ai < 2; ++ai)
#pragma unroll
            for (int m = 0; m < 4; ++m) { float* p = LOG + (size_t)(u.pm * 256 + ai * 128 + wr * 64 + m * 16 + fr) * 64 + wc * 32 + 8 * fq; *(f32x4*)p = acc[ai][0][m][0]; *(f32x4*)(p + 4) = acc[ai][0][m][1]; }
    }
};

struct MoeTables { const LAS int* cnt; const LAS int* tstart; const LAS int* pstart; };
DEV bool moe_unit(const MoeTables& T, int L, int& e, int& rt, int& pn) {
    const int total = T.tstart[32] * 4; if (L >= total) return false;
    const int rtg = L >> 2; pn = L & 3;
    int lo = 0, hi = 32;
    while (hi - lo > 1) { const int mid = (lo + hi) >> 1; if (T.tstart[mid] <= rtg) lo = mid; else hi = mid; }
    e = lo; rt = rtg - T.tstart[lo]; return true;
}
struct SchedMoe1 {
    static constexpr bool GATHER = true;
    const char* H; const char* W; const int* LTOK; MoeTables T; int G, c;
    DEV bool next(int i, GUnit& u) const {
        int e, rt, pn; if (!moe_unit(T, i * G + c, e, rt, pn)) return false;
        u.e = e; u.pm = rt; u.pn = pn; u.kind = 0; u.cnt = T.cnt[e]; u.ps = T.pstart[e]; u.a = H; u.b = W + (size_t)e * (1024 * 2048) + (size_t)pn * 256 * 2048; return true;
    }
    DEV void aoff(const GUnit& u, const int* R, const int* C, unsigned (&o)[2][2]) const {
#pragma unroll
        for (int h = 0; h < 2; ++h)
#pragma unroll
            for (int i = 0; i < 2; ++i) { const int pos = u.pm * 256 + 128 * h + R[i]; const int tok = pos < u.cnt ? LTOK[(size_t)u.e * 65536 + pos] : 0; o[h][i] = (unsigned)(tok * 1024 + C[i]) * 2u; }
    }
    DEV void mid(const GUnit&, int, f32x4 (&)[2][2][4][2], int, int) const {}
};
struct EpiMoe1 {
    bf16_t* HDN; const float* LRL; const float* LGATE;
    DEV void operator()(const f32x4 (&acc)[2][2][4][2], const GUnit& u, int wr, int wc, int fr, int fq) const {
#pragma unroll
        for (int ai = 0; ai < 2; ++ai)
#pragma unroll
            for (int m = 0; m < 4; ++m) { const int pos = u.pm * 256 + ai * 128 + wr * 64 + m * 16 + fr;
                const float r = pos < u.cnt ? LRL[(size_t)u.e * 65536 + pos] : 0.f, rg = pos < u.cnt ? r * LGATE[(size_t)u.e * 65536 + pos] : 0.f;
                float hv[8];
#pragma unroll
                for (int n = 0; n < 2; ++n)
#pragma unroll
                    for (int j = 0; j < 4; ++j) { const float g = acc[ai][0][m][n][j] * r, uu = acc[ai][1][m][n][j] * rg; hv[4 * n + j] = silu_f(g) * uu; }
                u32x4 w; w.x = pk_bf16(hv[0], hv[1]); w.y = pk_bf16(hv[2], hv[3]); w.z = pk_bf16(hv[4], hv[5]); w.w = pk_bf16(hv[6], hv[7]);
                *(u32x4*)(HDN + (size_t)(u.ps + pos) * 512 + u.pn * 128 + wc * 32 + 8 * fq) = w; }
    }
};
struct SchedMoe2 {
    static constexpr bool GATHER = false;
    const char* HDN; const char* W; MoeTables T; int G, c;
    DEV bool next(int i, GUnit& u) const {
        int e, rt, pn; if (!moe_unit(T, i * G + c, e, rt, pn)) return false;
        u.e = e; u.pm = rt; u.pn = pn; u.kind = 0; u.cnt = T.cnt[e]; u.ps = T.pstart[e];
        u.a = HDN + (size_t)(u.ps + rt * 256) * 1024; u.b = W + (size_t)e * (1024 * 1024) + (size_t)pn * 256 * 1024; return true;
    }
    DEV void aoff(const GUnit&, const int* R, const int* C, unsigned (&o)[2][2]) const { plain_aoff(R, C, 512, o); }
    DEV void mid(const GUnit&, int, f32x4 (&)[2][2][4][2], int, int) const {}
};
struct EpiMoe2 {
    bf16_t* Y;
    DEV void operator()(const f32x4 (&acc)[2][2][4][2], const GUnit& u, int wr, int wc, int fr, int fq) const {
        const int p = fr & 1;
#pragma unroll
        for (int ai = 0; ai < 2; ++ai)
#pragma unroll
            for (int m = 0; m < 4; ++m) { const int pos = u.pm * 256 + ai * 128 + wr * 64 + m * 16 + fr;
                u32x4 w[2];
#pragma unroll
                for (int bj = 0; bj < 2; ++bj) { const f32x4 v0 = acc[ai][bj][m][0], v1 = acc[ai][bj][m][1];
                    w[bj].x = pk_bf16(v0[0], v0[1]); w[bj].y = pk_bf16(v0[2], v0[3]); w[bj].z = pk_bf16(v1[0], v1[1]); w[bj].w = pk_bf16(v1[2], v1[3]); }
                u32x4 t0, t1;
#pragma unroll
                for (int q = 0; q < 4; ++q) { const unsigned offer = p ? w[0][q] : w[1][q];
                    const unsigned got = (unsigned)__builtin_amdgcn_update_dpp(0, (int)offer, 0xB1, 0xF, 0xF, false);
                    t0[q] = p ? got : w[0][q];
                    t1[q] = p ? w[1][q] : got; }
                bf16_t* rowp = Y + (size_t)(u.ps + pos - p) * 1024 + u.pn * 256 + wc * 64 + (p * 4 + fq) * 8;
                __builtin_nontemporal_store(t0, (u32x4*)rowp); __builtin_nontemporal_store(t1, (u32x4*)(rowp + 1024)); }
    }
};
}

namespace att {
constexpr int SLOT = 24576, NSLOT = 5, NT = SEQ / 64;
DEV int crow(int r, int hi) { return (r & 3) + 8 * (r >> 2) + 4 * hi; }

DEV float attn_map(LAS unsigned char* lds, const Params& P, int b, int h, int map, int qb, float cgeo, f32x16 (&o)[4]) {
    int tid_ = opaque_tid();
    const int tid = tid_, lane = tid & 63, wid = __builtin_amdgcn_readfirstlane(tid >> 6), l31 = lane & 31, hh = lane >> 5;
    const bf16_t* Q = (const bf16_t*)(P.ws + WS_Q); const bf16_t* Kg = (const bf16_t*)(P.ws + WS_K); const bf16_t* VT = (const bf16_t*)(P.ws + WS_VT);
    const unsigned* KMAX = (const unsigned*)(P.ws + WS_CTL) + 64;
    const size_t tokbase = (size_t)b * SEQ; const int Q0 = qb * 256, q0 = Q0 + wid * 32;
    bf16x8 qf[4];
    { const bf16_t* qp = Q + (tokbase + q0 + l31) * 512 + h * 128 + map * 64 + hh * 8;
#pragma unroll
      for (int ks = 0; ks < 4; ++ks) qf[ks] = *(const bf16x8*)(qp + ks * 16); }
    float s1 = 0.f;
#pragma unroll
    for (int ks = 0; ks < 4; ++ks)
#pragma unroll
        for (int j = 0; j < 8; ++j) { const float a = __uint_as_float(((unsigned)(unsigned short)qf[ks][j]) << 16); s1 += a * a; }
    s1 = sum_xor32(s1);
    const float M = sqrtf(s1 * __uint_as_float(KMAX[b * 8 + h * 2 + map])) * 1.002f + 0.02f;
    const float slope2 = exp2f(-2.f * (float)(h + 1)) * LOG2E;
    const float qpos = (float)(q0 + l31);
    LAS float* red = (LAS float*)(lds + NSLOT * SLOT);
    { float mw = M;
      mw = fmaxf(mw, xor_other<1>(mw)); mw = fmaxf(mw, xor_other<2>(mw)); mw = fmaxf(mw, xor_other<4>(mw)); mw = fmaxf(mw, xor_other<8>(mw)); mw = fmaxf(mw, xor_other<16>(mw));
      if (lane == 0) red[wid] = mw; }
    __syncthreads();
    float Mb = red[0];
#pragma unroll
    for (int w = 1; w < 8; ++w) Mb = fmaxf(Mb, red[w]);
    const int D = (int)fminf((2.f * Mb + cgeo) / slope2, 8192.f) + 1;
    const int t_lo = max(0, (Q0 - D - 63 + 63) >> 6) , t_hi = min(NT - 1, (Q0 + 255 + D) >> 6);
    const char* kbase = (const char*)(Kg + tokbase * 512 + h * 128 + map * 64);
    const char* vbase = (const char*)(VT + (size_t)(h * 128) * NTOK + tokbase);
    unsigned koff, voff;
    { const int L = tid, kv = L >> 3, cc = (L & 7) ^ ((kv >> 1) & 7); koff = (unsigned)(kv * 512 + cc * 8) * 2u; }
    { const int L = tid, d = L >> 3, cc = (L & 7) ^ ((d >> 1) & 7); voff = (unsigned)(d * NTOK + cc * 8) * 2u; }
    const unsigned ldsw = (unsigned)wid * 1024u;
#define ATT_DMA(t, sl) do { LAS unsigned char* _s = lds + (sl) * SLOT + ldsw; const char* _kb = kbase + (size_t)(t) * (64 * 512 * 2); const char* _vb = vbase + (size_t)(t) * 128; \
        __builtin_amdgcn_global_load_lds((const unsigned*)(_kb + koff), (LAS unsigned*)(_s), 16, 0, 0); \
        __builtin_amdgcn_global_load_lds((const unsigned*)(_vb + voff), (LAS unsigned*)(_s + 8192), 16, 0, 0); \
        __builtin_amdgcn_global_load_lds((const unsigned*)(_vb + (size_t)64 * NTOK * 2 + voff), (LAS unsigned*)(_s + 16384), 16, 0, 0); } while (0)
#define ATT_WAIT(k) do { if ((k) >= 3) asm volatile("s_waitcnt vmcnt(9)" ::: "memory"); else if ((k) == 2) asm volatile("s_waitcnt vmcnt(6)" ::: "memory"); else if ((k) == 1) asm volatile("s_waitcnt vmcnt(3)" ::: "memory"); else asm volatile("s_waitcnt vmcnt(0)" ::: "memory"); } while (0)
    const int swz = (l31 >> 1) & 7;
    const int rowb = l31 * 128;
#define ATT_CINIT(t, c0, c1) do { const int T_ = (t) * 64; const float dp0 = (float)(T_ + 4 * hh) - qpos; \
        if (T_ + 63 < q0) { const float bL = slope2 * dp0 - M; \
            _Pragma("unroll") for (int r = 0; r < 16; ++r) { c0[r] = fmaf(slope2, (float)((r & 3) + 8 * (r >> 2)), bL); c1[r] = fmaf(slope2, (float)(32 + (r & 3) + 8 * (r >> 2)), bL); } } \
        else if (T_ > q0 + 31) { const float bR = -slope2 * dp0 - M; \
            _Pragma("unroll") for (int r = 0; r < 16; ++r) { c0[r] = fmaf(-slope2, (float)((r & 3) + 8 * (r >> 2)), bR); c1[r] = fmaf(-slope2, (float)(32 + (r & 3) + 8 * (r >> 2)), bR); } } \
        else { _Pragma("unroll") for (int r = 0; r < 16; ++r) { c0[r] = -slope2 * fabsf(dp0 + (float)((r & 3) + 8 * (r >> 2))) - M; c1[r] = -slope2 * fabsf(dp0 + (float)(32 + (r & 3) + 8 * (r >> 2))) - M; } } } while (0)
#define ATT_QKMMA(sl, c0, c1) do { const LAS unsigned char* _kb = lds + (sl) * SLOT + rowb; \
        _Pragma("unroll") for (int ks = 0; ks < 4; ++ks) { const int _ko = ((2 * ks + hh) ^ swz) * 16; \
            const bf16x8 k0_ = *(const LAS bf16x8*)(_kb + _ko), k1_ = *(const LAS bf16x8*)(_kb + 4096 + _ko); \
            c0 = __builtin_amdgcn_mfma_f32_32x32x16_bf16(k0_, qf[ks], c0, 0, 0, 0); c1 = __builtin_amdgcn_mfma_f32_32x32x16_bf16(k1_, qf[ks], c1, 0, 0, 0); } } while (0)
#define ATT_EXP(c0, c1, pf) do { float ls0 = 0.f, ls1 = 0.f, ls2 = 0.f, ls3 = 0.f; \
        _Pragma("unroll") for (int r = 0; r < 16; r += 2) { c0[r] = fast_exp2(c0[r]); ls0 += c0[r]; c1[r] = fast_exp2(c1[r]); ls1 += c1[r]; c0[r + 1] = fast_exp2(c0[r + 1]); ls2 += c0[r + 1]; c1[r + 1] = fast_exp2(c1[r + 1]); ls3 += c1[r + 1]; } \
        lsum += (ls0 + ls1) + (ls2 + ls3); \
        _Pragma("unroll") for (int s_ = 0; s_ < 2; ++s_) { u32x4 w; w.x = pk_bf16(c0[8 * s_ + 0], c0[8 * s_ + 1]); w.y = pk_bf16(c0[8 * s_ + 2], c0[8 * s_ + 3]); w.z = pk_bf16(c0[8 * s_ + 4], c0[8 * s_ + 5]); w.w = pk_bf16(c0[8 * s_ + 6], c0[8 * s_ + 7]); pf[s_] = __builtin_bit_cast(bf16x8, w); \
            u32x4 w2; w2.x = pk_bf16(c1[8 * s_ + 0], c1[8 * s_ + 1]); w2.y = pk_bf16(c1[8 * s_ + 2], c1[8 * s_ + 3]); w2.z = pk_bf16(c1[8 * s_ + 4], c1[8 * s_ + 5]); w2.w = pk_bf16(c1[8 * s_ + 6], c1[8 * s_ + 7]); pf[2 + s_] = __builtin_bit_cast(bf16x8, w2); } } while (0)
#define ATT_SUMPACK(c0, c1, pf) do { float ls0 = 0.f, ls1 = 0.f, ls2 = 0.f, ls3 = 0.f; \
        _Pragma("unroll") for (int r = 0; r < 16; r += 2) { ls0 += c0[r]; ls1 += c1[r]; ls2 += c0[r + 1]; ls3 += c1[r + 1]; } \
        lsum += (ls0 + ls1) + (ls2 + ls3); \
        _Pragma("unroll") for (int s_ = 0; s_ < 2; ++s_) { u32x4 w; w.x = pk_bf16(c0[8 * s_ + 0], c0[8 * s_ + 1]); w.y = pk_bf16(c0[8 * s_ + 2], c0[8 * s_ + 3]); w.z = pk_bf16(c0[8 * s_ + 4], c0[8 * s_ + 5]); w.w = pk_bf16(c0[8 * s_ + 6], c0[8 * s_ + 7]); pf[s_] = __builtin_bit_cast(bf16x8, w); \
            u32x4 w2; w2.x = pk_bf16(c1[8 * s_ + 0], c1[8 * s_ + 1]); w2.y = pk_bf16(c1[8 * s_ + 2], c1[8 * s_ + 3]); w2.z = pk_bf16(c1[8 * s_ + 4], c1[8 * s_ + 5]); w2.w = pk_bf16(c1[8 * s_ + 6], c1[8 * s_ + 7]); pf[2 + s_] = __builtin_bit_cast(bf16x8, w2); } } while (0)
#define ATT_BAR() do { __builtin_amdgcn_sched_barrier(0); asm volatile("" ::: "memory"); __builtin_amdgcn_s_barrier(); asm volatile("" ::: "memory"); __builtin_amdgcn_sched_barrier(0); } while (0)
#pragma unroll
    for (int mt = 0; mt < 4; ++mt)
#pragma unroll
        for (int r = 0; r < 16; ++r) o[mt][r] = 0.f;
    float lsum = 0.f;
#define ATT_NEXT(sl) ((sl) + 1 >= NSLOT ? 0 : (sl) + 1)
#define ATT_SB() __builtin_amdgcn_sched_barrier(0)
    ATT_DMA(t_lo, 0); ATT_DMA(min(t_lo + 1, t_hi), 1); ATT_DMA(min(t_lo + 2, t_hi), 2); ATT_DMA(min(t_lo + 3, t_hi), 3);
    asm volatile("s_waitcnt vmcnt(6)" ::: "memory");
    ATT_BAR();
    f32x16 c0, c1; bf16x8 pf[4], fa[4], fb[4];
    ATT_CINIT(t_lo, c0, c1); ATT_QKMMA(0, c0, c1); ATT_EXP(c0, c1, pf);
    ATT_CINIT(t_lo + 1, c0, c1);
    { const LAS unsigned char* kb_ = lds + SLOT + rowb;
#pragma unroll
      for (int ks = 0; ks < 4; ++ks) { const int _ko = ((2 * ks + hh) ^ swz) * 16; fa[ks] = *(const LAS bf16x8*)(kb_ + _ko); fb[ks] = *(const LAS bf16x8*)(kb_ + 4096 + _ko); } }
    float ls0 = lsum, ls1 = 0.f, ls2 = 0.f, ls3 = 0.f;
    int sl = 0;
#define KF0(ks) fa[ks] = *(const LAS bf16x8*)(kb_ + (((2 * (ks) + hh) ^ swz) * 16))
#define KF1(ks) fb[ks] = *(const LAS bf16x8*)(kb_ + 4096 + (((2 * (ks) + hh) ^ swz) * 16))
#define VLD(dst, MT, S4) dst = *(const LAS bf16x8*)(vb_ + (MT) * 4096 + (((2 * (S4) + hh) ^ swz) * 16))
#define QK0(ks) c0 = __builtin_amdgcn_mfma_f32_32x32x16_bf16(fa[ks], qf[ks], c0, 0, 0, 0)
#define QK1(ks) c1 = __builtin_amdgcn_mfma_f32_32x32x16_bf16(fb[ks], qf[ks], c1, 0, 0, 0)
#define PV(MT, S4, V) o[MT] = __builtin_amdgcn_mfma_f32_32x32x16_bf16(V, pf[S4], o[MT], 0, 0, 0)
#define EX(c, R0, N) do { _Pragma("unroll") for (int r_ = 0; r_ < (N); ++r_) c[(R0) + r_] = fast_exp2(c[(R0) + r_]); } while (0)
#define SH(c, R0, LA, LB, W0, W1) do { LA = fadd_s(LA, c[R0]); LB = fadd_s(LB, c[(R0) + 1]); LA = fadd_s(LA, c[(R0) + 2]); LB = fadd_s(LB, c[(R0) + 3]); W0 = pk_bf16(c[R0], c[(R0) + 1]); W1 = pk_bf16(c[(R0) + 2], c[(R0) + 3]); } while (0)
#define PIN4(w) asm volatile("" : "+v"(w))
#define CI(c, R0, KOFF) do { _Pragma("unroll") for (int j_ = 0; j_ < 4; ++j_) c[(R0) + j_] = ffma_sk((float)((KOFF) + j_), sA, bA); } while (0)
#pragma unroll 1
    for (int t = t_lo; t < t_hi; ++t) {
        const int sl1 = ATT_NEXT(sl), sl2 = ATT_NEXT(sl1), sl4 = (sl == 0 ? NSLOT - 1 : sl - 1);
        const LAS unsigned char* vb_ = lds + sl * SLOT + 8192 + rowb;
        const LAS unsigned char* kb_ = lds + sl2 * SLOT + rowb;
        const int T2 = (t + 2) * 64, td = min(t + 4, t_hi);
        const float sA = (T2 < q0) ? slope2 : -slope2;
        const float dp2 = (float)(T2 + 4 * hh) - qpos, bA = fmaf(sA, dp2, -M);
        LAS unsigned char* ds_ = lds + sl4 * SLOT + ldsw; const char* dk_ = kbase + (size_t)td * (64 * 512 * 2); const char* dv_ = vbase + (size_t)td * 128;
        asm volatile("s_waitcnt vmcnt(3)" ::: "memory");
        ATT_BAR();
        u32x4 w;
        QK0(0); __builtin_amdgcn_global_load_lds((const unsigned*)(dk_ + koff), (LAS unsigned*)(ds_), 16, 0, 0); VLD(fa[0], 0, 0); ATT_SB();
        QK0(1); __builtin_amdgcn_global_load_lds((const unsigned*)(dv_ + voff), (LAS unsigned*)(ds_ + 8192), 16, 0, 0); VLD(fa[1], 1, 0); ATT_SB();
        QK0(2); __builtin_amdgcn_global_load_lds((const unsigned*)(dv_ + (size_t)64 * NTOK * 2 + voff), (LAS unsigned*)(ds_ + 16384), 16, 0, 0); VLD(fa[2], 2, 0); ATT_SB();
        QK0(3); VLD(fa[3], 3, 0); ATT_SB();
        QK1(0); VLD(fb[0], 0, 1); ATT_SB();
        QK1(1); VLD(fb[1], 1, 1); EX(c0, 0, 3); ATT_SB();
        QK1(2); VLD(fb[2], 2, 1); EX(c0, 3, 3); ATT_SB();
        QK1(3); VLD(fb[3], 3, 1); EX(c0, 6, 3); ATT_SB();
        PV(0, 0, fa[0]); VLD(fa[0], 0, 2); EX(c0, 9, 3); ATT_SB();
        PV(1, 0, fa[1]); VLD(fa[1], 1, 2); EX(c0, 12, 3); ATT_SB();
        PV(2, 0, fa[2]); VLD(fa[2], 2, 2); EX(c0, 15, 1); EX(c1, 0, 2); ATT_SB();
        PV(3, 0, fa[3]); VLD(fa[3], 3, 2); EX(c1, 2, 3); ATT_SB();
        PV(0, 1, fb[0]); VLD(fb[0], 0, 3); EX(c1, 5, 2); SH(c0, 0, ls0, ls1, w.x, w.y); ATT_SB();
        PV(1, 1, fb[1]); VLD(fb[1], 1, 3); EX(c1, 7, 2); SH(c0, 4, ls2, ls3, w.z, w.w); PIN4(w); pf[0] = __builtin_bit_cast(bf16x8, w); ATT_SB();
        PV(2, 1, fb[2]); VLD(fb[2], 2, 3); EX(c1, 9, 2); CI(c0, 0, 0); ATT_SB();
        PV(3, 1, fb[3]); VLD(fb[3], 3, 3); EX(c1, 11, 2); CI(c0, 4, 8); ATT_SB();
        PV(0, 2, fa[0]); KF0(0); EX(c1, 13, 2); SH(c0, 8, ls0, ls1, w.x, w.y); ATT_SB();
        PV(1, 2, fa[1]); KF0(1); EX(c1, 15, 1); SH(c0, 12, ls2, ls3, w.z, w.w); PIN4(w); pf[1] = __builtin_bit_cast(bf16x8, w); ATT_SB();
        PV(2, 2, fa[2]); KF0(2); CI(c0, 8, 16); ATT_SB();
        PV(3, 2, fa[3]); KF0(3); CI(c0, 12, 24); ATT_SB();
        PV(0, 3, fb[0]); KF1(0); SH(c1, 0, ls0, ls1, w.x, w.y); ATT_SB();
        PV(1, 3, fb[1]); KF1(1); SH(c1, 4, ls2, ls3, w.z, w.w); PIN4(w); pf[2] = __builtin_bit_cast(bf16x8, w); ATT_SB();
        PV(2, 3, fb[2]); KF1(2); CI(c1, 0, 32); CI(c1, 4, 40); ATT_SB();
        PV(3, 3, fb[3]); KF1(3); SH(c1, 8, ls0, ls1, w.x, w.y); SH(c1, 12, ls2, ls3, w.z, w.w); PIN4(w); pf[3] = __builtin_bit_cast(bf16x8, w); ATT_SB();
        CI(c1, 8, 48); CI(c1, 12, 56); ATT_SB();
        if (T2 + 63 >= q0 && T2 <= q0 + 31) {
#pragma unroll
            for (int r = 0; r < 16; ++r) { const float x0 = dp2 + (float)((r & 3) + 8 * (r >> 2)), x1 = x0 + 32.f;
                c0[r] = fmaf(-sA, x0, fmaf(-slope2, fabsf(x0), c0[r])); c1[r] = fmaf(-sA, x1, fmaf(-slope2, fabsf(x1), c1[r])); }
        }
        ATT_SB();
        sl = sl1;
    }
    lsum = (ls0 + ls1) + (ls2 + ls3);
    {
        const LAS unsigned char* vb_ = lds + sl * SLOT + 8192 + rowb;
        bf16x8 vfr[2][4];
#define ATT_VLOAD(S, MT) do { _Pragma("unroll") for (int s4 = 0; s4 < 4; ++s4) vfr[S][s4] = *(const LAS bf16x8*)(vb_ + (MT) * 4096 + (((2 * s4 + hh) ^ swz) * 16)); } while (0)
#define ATT_PV(S, MT) do { _Pragma("unroll") for (int s4 = 0; s4 < 4; ++s4) o[MT] = __builtin_amdgcn_mfma_f32_32x32x16_bf16(vfr[S][s4], pf[s4], o[MT], 0, 0, 0); } while (0)
        ATT_VLOAD(0, 0); ATT_VLOAD(1, 1); ATT_SB(); ATT_PV(0, 0); ATT_SB(); ATT_VLOAD(0, 2); ATT_SB(); ATT_PV(1, 1); ATT_SB(); ATT_VLOAD(1, 3); ATT_SB(); ATT_PV(0, 2); ATT_SB(); ATT_PV(1, 3);
        asm volatile("s_waitcnt vmcnt(0)" ::: "memory");
    }
#undef KF0
#undef KF1
#undef VLD
#undef QK0
#undef QK1
#undef PV
#undef EX
#undef SH
#undef CI
#undef PIN4
#undef ATT_NEXT
#undef ATT_VLOAD
#undef ATT_PV
#undef ATT_SB
#undef ATT_CINIT
#undef ATT_QKMMA
#undef ATT_BAR
#undef ATT_WAITX
#undef ATT_DMA
#undef ATT_WAIT
#undef ATT_QK
#undef ATT_EXP
    __syncthreads();
    lsum = sum_xor32(lsum);
    return lsum;
}

DEV void attn_unit(LAS unsigned char* lds, const Params& P, int b, int h, int qb, float lam, float cgeo) {
    int tid_ = opaque_tid();
    const int tid = tid_, lane = tid & 63, wid = __builtin_amdgcn_readfirstlane(tid >> 6), l31 = lane & 31, hh = lane >> 5;
    bf16_t* MIX = (bf16_t*)(P.ws + WS_MIX);
    const size_t tokbase = (size_t)b * SEQ; const int q0 = qb * 256 + wid * 32;
    f32x16 o[4];
    float* park = (float*)(P.ws + WS_U) + ((size_t)(blockIdx.x * 8 + wid) * 4096) + lane * 4;
    { const float l1 = attn_map(lds, P, b, h, 0, qb, cgeo, o); const float i1 = 1.f / l1;
#pragma unroll
      for (int mt = 0; mt < 4; ++mt)
#pragma unroll
          for (int g4 = 0; g4 < 4; ++g4) { f32x4 v; v[0] = o[mt][4 * g4] * i1; v[1] = o[mt][4 * g4 + 1] * i1; v[2] = o[mt][4 * g4 + 2] * i1; v[3] = o[mt][4 * g4 + 3] * i1; *(f32x4*)(park + (mt * 4 + g4) * 256) = v; } }
    const float l2 = attn_map(lds, P, b, h, 1, qb, cgeo, o);
    const float i2 = lam / l2;
    float ssq = 0.f;
#pragma unroll
    for (int mt = 0; mt < 4; ++mt) {
        __builtin_amdgcn_sched_barrier(0);
#pragma unroll
        for (int g4 = 0; g4 < 4; ++g4) { const f32x4 a = *(const f32x4*)(park + (mt * 4 + g4) * 256);
#pragma unroll
            for (int e = 0; e < 4; ++e) { const float v = a[e] - o[mt][4 * g4 + e] * i2; o[mt][4 * g4 + e] = v; ssq += v * v; } }
    }
    __builtin_amdgcn_sched_barrier(0);
    ssq = sum_xor32(ssq);
    const float rs = rsqrtf(ssq * (1.f / 128.f) + EPS) * (1.f - LAMBDA_INIT);
    LAS unsigned char* stg = lds + wid * 8704;
#pragma unroll
    for (int mt = 0; mt < 4; ++mt)
#pragma unroll
        for (int g4 = 0; g4 < 4; ++g4) { const int d0 = 32 * mt + 8 * g4 + 4 * hh; const f32x4 sw = *(const f32x4*)(P.subln_w + d0);
            u32x2 w; w.x = pk_bf16(o[mt][4 * g4 + 0] * rs * sw[0], o[mt][4 * g4 + 1] * rs * sw[1]); w.y = pk_bf16(o[mt][4 * g4 + 2] * rs * sw[2], o[mt][4 * g4 + 3] * rs * sw[3]);
            *(LAS u32x2*)(stg + l31 * 272 + d0 * 2) = w; }
    LDS_WAIT();
#pragma unroll
    for (int i = 0; i < 8; ++i) { const int row = i * 4 + (lane >> 4), ck = lane & 15;
        const u32x4 v = *(const LAS u32x4*)(stg + row * 272 + ck * 16);
        *(u32x4*)(MIX + (tokbase + q0 + row) * DM + 512 + h * 128 + ck * 8) = v; }
    __syncthreads();
}

DEV void attn_phase(LAS unsigned char* lds, const Params& P) {
    const int lane = opaque_tid() & 63;
    const float d1 = wave_sum(P.lq1[lane] * P.lk1[lane]), d2 = wave_sum(P.lq2[lane] * P.lk2[lane]);
    const float lam = expf(d1) - expf(d2) + LAMBDA_INIT;
    for (int u0 = blockIdx.x; u0 < NBATCH * 16; u0 += gridDim.x) {
        const int x = u0 & 7, idx = u0 >> 3, b = 2 * x + (idx >> 4), qb = idx & 15;
#pragma unroll 1
        for (int h = 0; h < 4; ++h) { const float sl2 = exp2f(-2.f * (float)(h + 1)) * LOG2E;
            attn_unit(lds, P, b, h, qb, lam, 29.f + log2f(1.f / (1.f - exp2f(-sl2)))); }
    }
}
}

namespace ssd {
constexpr int PITCH = 272;
DEV int crow(int r, int hi) { return (r & 3) + 8 * (r >> 2) + 4 * hi; }
DEV float softplus_f(float v) { return v > 15.f ? v : 0.6931471805599453f * __builtin_amdgcn_logf(1.f + fast_exp2(v * LOG2E)); }

DEV void conv8x8(const bf16_t* XBC, int b, int t0, int ch0, const float* cw, const float* cb, u32x4 (&outp)[8]) {
    u32x4 rows[12];
#pragma unroll
    for (int i = 0; i < 12; ++i) { const int t = t0 - 2 + i; u32x4 z = {0u, 0u, 0u, 0u};
        rows[i] = (t >= 0 && t < SEQ) ? *(const u32x4*)(XBC + ((size_t)b * SEQ + t) * 1024 + ch0) : z; }
#pragma unroll
    for (int q = 0; q < 4; ++q) {
        float i0[12], i1[12];
#pragma unroll
        for (int i = 0; i < 12; ++i) { const unsigned u = rows[i][q]; i0[i] = bflo(u); i1[i] = bfhi(u); }
        float w0[5], w1[5];
#pragma unroll
        for (int j = 0; j < 5; ++j) { const float2 w = *(const float2*)(cw + j * 1024 + ch0 + 2 * q); w0[j] = w.x; w1[j] = w.y; }
        const float2 bb = *(const float2*)(cb + ch0 + 2 * q); const float b0 = bb.x, b1 = bb.y;
#pragma unroll
        for (int tk = 0; tk < 8; ++tk) { float a0 = b0, a1 = b1;
#pragma unroll
            for (int j = 0; j < 5; ++j) { a0 += w0[j] * i0[tk + j]; a1 += w1[j] * i1[tk + j]; }
            outp[tk][q] = pk_bf16(silu_f(a0), silu_f(a1)); }
    }
}
template <bool WGT> DEV u32x4 tr_chan(const u32x4 (&outp)[8], int k, const float (&wgt)[8]) {
    float v[8];
#pragma unroll
    for (int tk = 0; tk < 8; ++tk) { const unsigned u = outp[tk][k >> 1]; v[tk] = (k & 1) ? bfhi(u) : bflo(u); if (WGT) v[tk] *= wgt[tk]; }
    u32x4 w; w.x = pk_bf16(v[0], v[1]); w.y = pk_bf16(v[2], v[3]); w.z = pk_bf16(v[4], v[5]); w.w = pk_bf16(v[6], v[7]); return w;
}

DEV void dt_tables(const Params& P, LAS float* A1, LAS float* A2, LAS float* A3, LAS float* A4, int tok0, int g) {
    int tid_ = opaque_tid();
    const int tid = tid_, lane = tid & 63, wid = tid >> 6;
    const float* DT = (const float*)(P.ws + WS_DT);
    {
        const int t = tid & 127, r = tid >> 7, hd = 4 * g + r;
        const float dtf = softplus_f(DT[(size_t)(tok0 + t) * 16 + hd] + P.dt_bias_f[hd]), dtb = softplus_f(DT[(size_t)(tok0 + t) * 16 + 8 + hd] + P.dt_bias_b[hd]);
        A1[r * 128 + t] = -dtf * fast_exp2(P.a_log_f[hd] * LOG2E) * LOG2E; A2[r * 128 + t] = -dtb * fast_exp2(P.a_log_b[hd] * LOG2E) * LOG2E;
        A3[r * 128 + t] = __builtin_amdgcn_logf(dtf); A4[r * 128 + t] = __builtin_amdgcn_logf(dtb);
    }
    __syncthreads();
    {
        const int r = wid & 3, dir = wid >> 2; LAS float* arr = (dir ? A2 : A1) + r * 128; LAS float* qa = (dir ? A4 : A3) + r * 128;
        const float v0 = arr[2 * lane], v1 = arr[2 * lane + 1], pair = v0 + v1; float incl = pair;
#pragma unroll
        for (int o = 1; o < 64; o <<= 1) { const float n = __int_as_float(__builtin_amdgcn_ds_bpermute((lane - o) << 2, __float_as_int(incl))); if (lane >= o) incl += n; }
        float o0, o1;
        if (dir == 0) { o0 = incl - v1; o1 = incl; }
        else { const float tot = __int_as_float(__builtin_amdgcn_readlane(__float_as_int(incl), 63)); o0 = tot - (incl - pair); o1 = tot - (incl - v1); }
        const float l0 = qa[2 * lane], l1 = qa[2 * lane + 1];
        arr[2 * lane] = o0; arr[2 * lane + 1] = o1; qa[2 * lane] = o0 - l0; qa[2 * lane + 1] = o1 - l1;
    }
    __syncthreads();
}

DEV void state_unit(LAS unsigned char* lds, const Params& P, int b, int c, int g) {
    int tid_ = opaque_tid();
    const int tid = tid_, lane = tid & 63, wid = __builtin_amdgcn_readfirstlane(tid >> 6), l31 = lane & 31, hh = lane >> 5;
    const bf16_t* XBC = (const bf16_t*)(P.ws + WS_XBC); bf16_t* ST = (bf16_t*)(P.ws + WS_ST); float* CD = (float*)(P.ws + WS_CD);
    LAS unsigned char* XWT = lds;
    LAS unsigned char* BT = lds + 256 * PITCH;
    LAS float* A1 = (LAS float*)(lds + 384 * PITCH); LAS float* A2 = A1 + 512; LAS float* A3 = A2 + 512; LAS float* A4 = A3 + 512;
    const int tok0 = b * SEQ + c * 128;
    __syncthreads();
    dt_tables(P, A1, A2, A3, A4, tok0, g);
    { float* TB = (float*)(P.ws + WS_DTT) + (size_t)((b * NCHUNK + c) * 2 + g) * 2048; *(f32x4*)(TB + tid * 4) = *(const LAS f32x4*)(A1 + tid * 4); }
    if (tid < 8) { const int r = tid & 3, dir = tid >> 2; CD[(size_t)((b * NCHUNK + c) * 2 + dir) * 8 + 4 * g + r] = fast_exp2(dir ? A2[r * 128] : A1[r * 128 + 127]); }
    bf16_t* XCX = (bf16_t*)(P.ws + WS_XCX); bf16_t* XCBC = (bf16_t*)(P.ws + WS_XCBC);
    u32x4 xo[2][8]; const float one8[8] = {1.f, 1.f, 1.f, 1.f, 1.f, 1.f, 1.f, 1.f};
#pragma unroll
    for (int it = 0; it < 2; ++it) { const int slot = it * 512 + tid, cg_ = slot & 63, run = slot >> 6;
        const int ch = cg_ < 32 ? g * 256 + 8 * cg_ : (cg_ < 48 ? 512 + g * 128 + 8 * (cg_ - 32) : 768 + g * 128 + 8 * (cg_ - 48));
        conv8x8(XBC, b, c * 128 + 8 * run, ch, P.conv_w, P.conv_b, xo[it]);
        bf16_t* gdst = cg_ < 32 ? XCX + (size_t)(tok0 + 8 * run) * 512 + (ch) : XCBC + (size_t)(tok0 + 8 * run) * 512 + (ch - 512);
#pragma unroll
        for (int tk = 0; tk < 8; ++tk) __builtin_nontemporal_store(xo[it][tk], (u32x4*)(gdst + (size_t)tk * 512));
        if (cg_ >= 32 && cg_ < 48) {
#pragma unroll
            for (int k = 0; k < 8; ++k) *(LAS u32x4*)(BT + (8 * (cg_ - 32) + k) * PITCH + 16 * run) = tr_chan<false>(xo[it], k, one8); } }
#pragma unroll 1
    for (int dir = 0; dir < 2; ++dir) {
        if (dir) __syncthreads();
#pragma unroll
        for (int it = 0; it < 2; ++it) { const int slot = it * 512 + tid, cg_ = slot & 63, run = slot >> 6;
            if (cg_ < 32) { const int r = cg_ >> 3; const float ref = dir ? A2[r * 128] : A1[r * 128 + 127]; const LAS float* qa = (dir ? A4 : A3) + r * 128 + 8 * run;
                float wg[8];
#pragma unroll
                for (int tk = 0; tk < 8; ++tk) wg[tk] = fast_exp2(ref - qa[tk]);
#pragma unroll
                for (int k = 0; k < 8; ++k) *(LAS u32x4*)(XWT + (8 * cg_ + k) * PITCH + 16 * run) = tr_chan<true>(xo[it], k, wg); } }
        __syncthreads();
        const int r = wid & 3, ph = wid >> 2;
        f32x16 acc[4];
#pragma unroll
        for (int nt = 0; nt < 4; ++nt)
#pragma unroll
            for (int q = 0; q < 16; ++q) acc[nt][q] = 0.f;
#pragma unroll
        for (int ks = 0; ks < 8; ++ks) {
            const bf16x8 af = *(const LAS bf16x8*)(XWT + (64 * r + 32 * ph + l31) * PITCH + (16 * ks + 8 * hh) * 2);
#pragma unroll
            for (int nt = 0; nt < 4; ++nt) { const bf16x8 bf = *(const LAS bf16x8*)(BT + (32 * nt + l31) * PITCH + (16 * ks + 8 * hh) * 2);
                acc[nt] = __builtin_amdgcn_mfma_f32_32x32x16_bf16(af, bf, acc[nt], 0, 0, 0); }
        }
        bf16_t* dst = ST + ((size_t)(((b * NCHUNK + c) * 2 + dir) * 8 + 4 * g + r)) * 8192 + (size_t)ph * 512;
        LAS unsigned char* stg = XWT + (64 * r + 32 * ph) * PITCH;
#pragma unroll
        for (int nt = 0; nt < 4; ++nt)
#pragma unroll
            for (int q = 0; q < 16; ++q) *(LAS bf16_t*)(stg + crow(q, hh) * PITCH + (32 * nt + l31) * 2) = (bf16_t)(pk_bf16(acc[nt][q], 0.f) & 0xffffu);
        LDS_WAIT();
#pragma unroll
        for (int i = 0; i < 8; ++i) { const int row = i * 4 + (lane >> 4), ck = lane & 15;
            *(u32x4*)(dst + (((ck >> 1) * 2) * 32 + row) * 16 + (ck & 1) * 8) = *(const LAS u32x4*)(stg + row * PITCH + ck * 16); }
    }
}

DEV void state_phase(LAS unsigned char* lds, const Params& P) {
    for (int u = blockIdx.x; u < NBATCH * NCHUNK * 2; u += gridDim.x) state_unit(lds, P, u >> 6, (u >> 1) & 31, u & 1);
    const int tid = opaque_tid(), lane = tid & 63, wave = tid >> 6, gw = blockIdx.x * 8 + wave, NGW = gridDim.x * 8;
    const bf16_t* Kg = (const bf16_t*)(P.ws + WS_K); unsigned* KMAX = (unsigned*)(P.ws + WS_CTL) + 64;
    for (int blk = gw; blk < NTOK / 32; blk += NGW) {
        float m = 0.f;
#pragma unroll 4
        for (int i = 0; i < 32; ++i) { const u32x4 v = *(const u32x4*)(Kg + (size_t)(blk * 32 + i) * 512 + lane * 8); float s = 0.f;
#pragma unroll
            for (int q = 0; q < 4; ++q) { const float a = bflo(v[q]), c = bfhi(v[q]); s += a * a + c * c; }
            s += xor_other<1>(s); s += xor_other<2>(s); s += xor_other<4>(s); m = fmaxf(m, s); }
        if ((lane & 7) == 0) atomicMax(&KMAX[((blk * 32) / SEQ) * 8 + (lane >> 3)], __float_as_uint(m));
    }
}

DEV void scan_phase(const Params& P) {
    bf16_t* ST = (bf16_t*)(P.ws + WS_ST); const float* CD = (const float*)(P.ws + WS_CD);
    const int gt = blockIdx.x * 512 + opaque_tid(), NGT = gridDim.x * 512;
    for (int item = gt; item < NBATCH * 2 * 8 * 64 * 16; item += NGT) {
        const int n8 = item & 15, p = (item >> 4) & 63, hd = (item >> 10) & 7, dir = (item >> 13) & 1, b = item >> 14;
        float acc[8];
#pragma unroll
        for (int k = 0; k < 8; ++k) acc[k] = 0.f;
        for (int s0 = 0; s0 < NCHUNK; s0 += 8) {
            u32x4 sv[8]; float dv[8];
#pragma unroll
            for (int j = 0; j < 8; ++j) { const int c = dir ? NCHUNK - 1 - (s0 + j) : s0 + j; const size_t ci = (size_t)((b * NCHUNK + c) * 2 + dir) * 8 + hd;
                sv[j] = *(const u32x4*)(ST + ci * 8192 + p * 128 + n8 * 8); dv[j] = CD[ci]; }
#pragma unroll
            for (int j = 0; j < 8; ++j) { const int c = dir ? NCHUNK - 1 - (s0 + j) : s0 + j; const size_t ci = (size_t)((b * NCHUNK + c) * 2 + dir) * 8 + hd;
                u32x4 w; w.x = pk_bf16(acc[0], acc[1]); w.y = pk_bf16(acc[2], acc[3]); w.z = pk_bf16(acc[4], acc[5]); w.w = pk_bf16(acc[6], acc[7]);
                __builtin_nontemporal_store(w, (u32x4*)(ST + ci * 8192 + p * 128 + n8 * 8));
#pragma unroll
                for (int q = 0; q < 4; ++q) { acc[2 * q] = dv[j] * acc[2 * q] + bflo(sv[j][q]); acc[2 * q + 1] = dv[j] * acc[2 * q + 1] + bfhi(sv[j][q]); } }
        }
    }
}

DEV void out_unit(LAS unsigned char* lds, const Params& P, int b, int c) {
    int tid_ = opaque_tid();
    const int tid = tid_, wid = __builtin_amdgcn_readfirstlane(tid >> 6);
    const bf16_t* XBC = (const bf16_t*)(P.ws + WS_XBC); const bf16_t* ST = (const bf16_t*)(P.ws + WS_ST); const bf16_t* Z = (const bf16_t*)(P.ws + WS_Z);
    bf16_t* MIX = (bf16_t*)(P.ws + WS_MIX); float* RLS = (float*)(P.ws + WS_RLS);
    LAS unsigned char* XT = lds;
    LAS unsigned char* BN = lds + 256 * PITCH;
    LAS unsigned char* CN = lds + 384 * PITCH;
    LAS float* A1 = (LAS float*)(lds + 512 * PITCH); LAS float* A2 = A1 + 512; LAS float* A3 = A2 + 512; LAS float* A4 = A3 + 512;
    LAS float* SSQ = A4 + 512;
    const int tok0 = b * SEQ + c * 128;
    for (int g = 0; g < 2; ++g) {
        unsigned pfh0, pfh1;
        { const unsigned char* hb0 = (const unsigned char*)(ST + ((size_t)(((b * NCHUNK + c) * 2 + 0) * 8 + 4 * g)) * 8192) + (size_t)tid * 128;
          pfh0 = *(const unsigned*)hb0; pfh1 = *(const unsigned*)(hb0 + (size_t)8 * 8192 * 2);
          pfh0 ^= *(const unsigned*)((const unsigned char*)(Z + (size_t)(tok0 + (tid >> 2)) * 512 + g * 256) + (tid & 3) * 128); }
        __syncthreads();
        { const float* TB = (const float*)(P.ws + WS_DTT) + (size_t)((b * NCHUNK + c) * 2 + g) * 2048; *(LAS f32x4*)(A1 + tid * 4) = *(const f32x4*)(TB + tid * 4); }
#pragma unroll 1
        for (int it = 0; it < 2; ++it) { int tc = tid; asm volatile("" : "+v"(tc)); const int slot = it * 512 + tc, cg_ = slot & 63, run = slot >> 6;
            const bf16_t* gsrc = cg_ < 32 ? (const bf16_t*)(P.ws + WS_XCX) + (size_t)(tok0 + 8 * run) * 512 + g * 256 + 8 * cg_
                                          : (const bf16_t*)(P.ws + WS_XCBC) + (size_t)(tok0 + 8 * run) * 512 + (cg_ < 48 ? g * 128 + 8 * (cg_ - 32) : 256 + g * 128 + 8 * (cg_ - 48));
            u32x4 xo[8]; const float one8[8] = {1.f, 1.f, 1.f, 1.f, 1.f, 1.f, 1.f, 1.f};
#pragma unroll
            for (int tk = 0; tk < 8; ++tk) xo[tk] = *(const u32x4*)(gsrc + (size_t)tk * 512);
            if (cg_ < 32) {
#pragma unroll
                for (int k = 0; k < 8; ++k) *(LAS u32x4*)(XT + (8 * cg_ + k) * PITCH + 16 * run) = tr_chan<false>(xo, k, one8);
            } else { LAS unsigned char* dst = (cg_ < 48 ? BN + 16 * (cg_ - 32) : CN + 16 * (cg_ - 48));
#pragma unroll
                for (int tk = 0; tk < 8; ++tk) *(LAS u32x4*)(dst + (8 * run + tk) * PITCH) = xo[tk]; } }
        asm volatile("" :: "v"(pfh0), "v"(pfh1));
        __syncthreads();
        int tq = tid; asm volatile("" : "+v"(tq));
        const int l31 = tq & 31, hh = (tq >> 5) & 1;
        const int li = wid & 3, hp = wid >> 2, l = 32 * li + l31;
        const LAS unsigned char* cfp = CN + l * PITCH + 16 * hh;
#pragma unroll 1
        for (int rr = 0; rr < 2; ++rr) {
            const int r = 2 * hp + rr, hd = 4 * g + r;
            const float af_l = A1[r * 128 + l], rb_l = A2[r * 128 + l], dskip = P.ssd_d[hd];
            const bf16_t* Hf = ST + ((size_t)(((b * NCHUNK + c) * 2 + 0) * 8 + hd)) * 8192 + l31 * 16 + 8 * hh;
            const bf16_t* Hb = Hf + (size_t)8 * 8192;
            bf16x8 hA[2][2], hB[2][2];
#define SSD_HLOAD(dst, src, k0) do { _Pragma("unroll") for (int ks = 0; ks < 2; ++ks) _Pragma("unroll") for (int mt = 0; mt < 2; ++mt) dst[ks][mt] = *(const bf16x8*)((src) + (((k0) + ks) * 2 + mt) * 512); } while (0)
#define SSD_HMMA(fr, k0, e) do { _Pragma("unroll") for (int ks = 0; ks < 2; ++ks) { const u32x4 cw = *(const LAS u32x4*)(cfp + 32 * ((k0) + ks)); \
                u32x4 ce; ce.x = pk_bf16(bflo(cw.x) * (e), bfhi(cw.x) * (e)); ce.y = pk_bf16(bflo(cw.y) * (e), bfhi(cw.y) * (e)); ce.z = pk_bf16(bflo(cw.z) * (e), bfhi(cw.z) * (e)); ce.w = pk_bf16(bflo(cw.w) * (e), bfhi(cw.w) * (e)); \
                const bf16x8 cfe = __builtin_bit_cast(bf16x8, ce); \
                _Pragma("unroll") for (int mt = 0; mt < 2; ++mt) yT[mt] = __builtin_amdgcn_mfma_f32_32x32x16_bf16(fr[ks][mt], cfe, yT[mt], 0, 0, 0); } } while (0)
            SSD_HLOAD(hA, Hf, 0);
            __builtin_amdgcn_sched_barrier(0);
            f32x16 cbt[4];
#pragma unroll
            for (int si = 0; si < 4; ++si)
#pragma unroll
                for (int q = 0; q < 16; ++q) cbt[si][q] = 0.f;
#pragma unroll
            for (int ks = 0; ks < 8; ++ks) {
                __builtin_amdgcn_sched_barrier(0);
                const bf16x8 cfk = *(const LAS bf16x8*)(cfp + 32 * ks);
#pragma unroll
                for (int si = 0; si < 4; ++si) { const bf16x8 bf = *(const LAS bf16x8*)(BN + (32 * si + l31) * PITCH + (16 * ks + 8 * hh) * 2);
                    cbt[si] = __builtin_amdgcn_mfma_f32_32x32x16_bf16(bf, cfk, cbt[si], 0, 0, 0); }
            }
            f32x16 yT[2];
#pragma unroll
            for (int mt = 0; mt < 2; ++mt)
#pragma unroll
                for (int q = 0; q < 16; ++q) yT[mt][q] = 0.f;
#pragma unroll
            for (int si = 0; si < 4; ++si) {
                __builtin_amdgcn_sched_barrier(0);
                f32x16 mv;
                if (si < li) {
#pragma unroll
                    for (int q4 = 0; q4 < 4; ++q4) { const f32x4 qf4 = *(const LAS f32x4*)(A3 + r * 128 + 32 * si + 8 * q4 + 4 * hh);
#pragma unroll
                        for (int e = 0; e < 4; ++e) mv[4 * q4 + e] = cbt[si][4 * q4 + e] * fast_exp2(af_l - qf4[e]); }
                } else if (si > li) {
#pragma unroll
                    for (int q4 = 0; q4 < 4; ++q4) { const f32x4 qb4 = *(const LAS f32x4*)(A4 + r * 128 + 32 * si + 8 * q4 + 4 * hh);
#pragma unroll
                        for (int e = 0; e < 4; ++e) mv[4 * q4 + e] = cbt[si][4 * q4 + e] * fast_exp2(rb_l - qb4[e]); }
                } else {
                    int lq = l; asm volatile("" : "+v"(lq));
#pragma unroll
                    for (int q4 = 0; q4 < 4; ++q4) { const int s0 = 32 * si + 8 * q4 + 4 * hh;
                        const f32x4 qf4 = *(const LAS f32x4*)(A3 + r * 128 + s0), qb4 = *(const LAS f32x4*)(A4 + r * 128 + s0);
                        __builtin_amdgcn_sched_barrier(0);
#pragma unroll
                        for (int e = 0; e < 4; ++e) { const int s = s0 + e;
                            const float gf = (s <= lq) ? fast_exp2(af_l - qf4[e]) : 0.f, gb = (s >= lq) ? fast_exp2(rb_l - qb4[e]) : 0.f;
                            mv[4 * q4 + e] = cbt[si][4 * q4 + e] * (gf + gb) + ((s == lq) ? dskip : 0.f); } }
                }
                bf16x8 mf[2];
#pragma unroll
                for (int s2 = 0; s2 < 2; ++s2) { u32x4 w; w.x = pk_bf16(mv[8 * s2 + 0], mv[8 * s2 + 1]); w.y = pk_bf16(mv[8 * s2 + 2], mv[8 * s2 + 3]); w.z = pk_bf16(mv[8 * s2 + 4], mv[8 * s2 + 5]); w.w = pk_bf16(mv[8 * s2 + 6], mv[8 * s2 + 7]); mf[s2] = __builtin_bit_cast(bf16x8, w); }
#pragma unroll
                for (int s2 = 0; s2 < 2; ++s2)
#pragma unroll
                    for (int mt = 0; mt < 2; ++mt) { const LAS unsigned char* xp = XT + (64 * r + 32 * mt + l31) * PITCH + (32 * si + 16 * s2 + 4 * hh) * 2;
                        const u32x2 xa = *(const LAS u32x2*)xp, xb = *(const LAS u32x2*)(xp + 16);
                        u32x4 xw; xw.x = xa.x; xw.y = xa.y; xw.z = xb.x; xw.w = xb.y;
                        yT[mt] = __builtin_amdgcn_mfma_f32_32x32x16_bf16(__builtin_bit_cast(bf16x8, xw), mf[s2], yT[mt], 0, 0, 0); }
            }
            { const float ef = fast_exp2(af_l), eb = fast_exp2(rb_l);
#define SSD_SB() __builtin_amdgcn_sched_barrier(0)
              bf16x8 hC[2][2], hD[2][2];
              SSD_SB(); SSD_HLOAD(hB, Hf, 2); SSD_HLOAD(hC, Hf, 4); SSD_HLOAD(hD, Hf, 6);
              SSD_SB(); SSD_HMMA(hA, 0, ef); SSD_SB();
              SSD_HLOAD(hA, Hb, 0); SSD_SB(); SSD_HMMA(hB, 2, ef); SSD_SB();
              SSD_HLOAD(hB, Hb, 2); SSD_SB(); SSD_HMMA(hC, 4, ef); SSD_SB();
              SSD_HLOAD(hC, Hb, 4); SSD_SB(); SSD_HMMA(hD, 6, ef); SSD_SB();
              SSD_HLOAD(hD, Hb, 6); SSD_SB(); SSD_HMMA(hA, 0, eb); SSD_SB();
              SSD_HMMA(hB, 2, eb); SSD_SB();
              SSD_HMMA(hC, 4, eb); SSD_SB();
              SSD_HMMA(hD, 6, eb); SSD_SB(); }
#undef SSD_SB
#undef SSD_HLOAD
#undef SSD_HMMA
            float ssq = 0.f;
            __builtin_amdgcn_sched_barrier(0);
#define SWAP32(a_, b_) do { const auto rr_ = __builtin_amdgcn_permlane32_swap((a_), (b_), false, false); (a_) = rr_[0]; (b_) = rr_[1]; } while (0)
#pragma unroll
            for (int mt = 0; mt < 2; ++mt)
#pragma unroll
                for (int j = 0; j < 2; ++j) { __builtin_amdgcn_sched_barrier(0); const int chb = g * 256 + 64 * r + 32 * mt + 16 * j;
                    u32x4 zl = *(const u32x4*)(Z + (size_t)(tok0 + l) * 512 + chb + 8 * hh);
                    SWAP32(zl.x, zl.z); SWAP32(zl.y, zl.w);
                    u32x2 w[2];
#pragma unroll
                    for (int o = 0; o < 2; ++o) { const int q4 = 2 * j + o; const f32x4 nw = *(const f32x4*)(P.ssd_norm_w + chb + 8 * o + 4 * hh);
                        const unsigned z0 = o ? zl.z : zl.x, z1 = o ? zl.w : zl.y;
                        const float g0 = yT[mt][4 * q4 + 0] * silu_f(bflo(z0)), g1 = yT[mt][4 * q4 + 1] * silu_f(bfhi(z0)), g2 = yT[mt][4 * q4 + 2] * silu_f(bflo(z1)), g3 = yT[mt][4 * q4 + 3] * silu_f(bfhi(z1));
                        ssq += (g0 * g0 + g1 * g1) + (g2 * g2 + g3 * g3);
                        w[o].x = pk_bf16(g0 * nw[0], g1 * nw[1]); w[o].y = pk_bf16(g2 * nw[2], g3 * nw[3]); }
                    SWAP32(w[0].x, w[1].x); SWAP32(w[0].y, w[1].y);
                    u32x4 ow; ow.x = w[0].x; ow.y = w[0].y; ow.z = w[1].x; ow.w = w[1].y;
                    *(u32x4*)(MIX + (size_t)(tok0 + l) * DM + chb + 8 * hh) = ow; }
#undef SWAP32
            SSQ[l * 16 + hd * 2 + hh] = ssq;
        }
    }
    __syncthreads();
    if (tid < 128) { float s = 0.f;
#pragma unroll
        for (int j = 0; j < 16; ++j) s += SSQ[tid * 16 + j];
        RLS[tok0 + tid] = rsqrtf(s * (1.f / 512.f) + EPS); }
}
DEV void out_phase(LAS unsigned char* lds, const Params& P) {
    for (int u = blockIdx.x; u < NBATCH * NCHUNK; u += gridDim.x) out_unit(lds, P, u >> 5, u & 31);
}
}

DEV void route_phase(LAS unsigned char* lds, const Params& P) {
    const int tid = opaque_tid();
    LAS unsigned* hist = (LAS unsigned*)(lds); LAS unsigned* base = hist + 32;
    const float* LOG = (const float*)(P.ws + WS_LOG); const float* RSS = (const float*)(P.ws + WS_RSS);
    unsigned* cnt = (unsigned*)(P.ws + WS_CTL);
    int* LTOK = (int*)(P.ws + WS_LTOK); float* LGATE = (float*)(P.ws + WS_LGATE); float* LRL = (float*)(P.ws + WS_LRL); unsigned* TOKEP = (unsigned*)(P.ws + WS_TOKEP);
    for (int tb = blockIdx.x; tb < NTOK / 512; tb += gridDim.x) {
        __syncthreads();
        if (tid < 32) hist[tid] = 0u;
        __syncthreads();
        const int t = tb * 512 + tid;
        float ss = 0.f;
#pragma unroll
        for (int j = 0; j < 4; ++j) { const f32x4 v = *(const f32x4*)(RSS + (size_t)t * 16 + 4 * j); ss += (v[0] + v[1]) + (v[2] + v[3]); }
        const float r = rsqrtf(ss * (1.f / DM) + EPS);
        const f32x4 gl4 = *(const f32x4*)(LOG + (size_t)t * 64);
        float gl[4];
#pragma unroll
        for (int j = 0; j < 4; ++j) gl[j] = gl4[j] * r + P.b_rg[j];
        int g = 0; float gm = gl[0];
#pragma unroll
        for (int j = 1; j < 4; ++j) if (gl[j] > gm) { gm = gl[j]; g = j; }
        float gs = 0.f;
#pragma unroll
        for (int j = 0; j < 4; ++j) gs += expf(gl[j] - gm);
        const float pg = 1.f / gs;
        const f32x4 e0 = *(const f32x4*)(LOG + (size_t)t * 64 + 4 + 8 * g), e1 = *(const f32x4*)(LOG + (size_t)t * 64 + 8 + 8 * g);
        const f32x4 b0 = *(const f32x4*)(P.b_re + 8 * g), b1 = *(const f32x4*)(P.b_re + 8 * g + 4);
        float el[8];
#pragma unroll
        for (int j = 0; j < 4; ++j) { el[j] = e0[j] * r + b0[j]; el[4 + j] = e1[j] * r + b1[j]; }
        int i1 = 0; float m1 = el[0];
#pragma unroll
        for (int j = 1; j < 8; ++j) if (el[j] > m1) { m1 = el[j]; i1 = j; }
        int i2 = -1; float m2 = -INFINITY;
#pragma unroll
        for (int j = 0; j < 8; ++j) if (j != i1 && el[j] > m2) { m2 = el[j]; i2 = j; }
        const float w1 = 1.f / (1.f + expf(m2 - m1)), w2 = 1.f - w1;
        const int ex1 = 8 * g + i1, ex2 = 8 * g + i2;
        const unsigned k1 = __hip_atomic_fetch_add(&hist[ex1], 1u, __ATOMIC_RELAXED, __HIP_MEMORY_SCOPE_WORKGROUP), k2 = __hip_atomic_fetch_add(&hist[ex2], 1u, __ATOMIC_RELAXED, __HIP_MEMORY_SCOPE_WORKGROUP);
        __syncthreads();
        if (tid < 32) base[tid] = atomicAdd(&cnt[tid], hist[tid]);
        __syncthreads();
        const unsigned p1 = base[ex1] + k1, p2 = base[ex2] + k2;
        LTOK[(size_t)ex1 * 65536 + p1] = t; LGATE[(size_t)ex1 * 65536 + p1] = pg * w1; LRL[(size_t)ex1 * 65536 + p1] = r;
        LTOK[(size_t)ex2 * 65536 + p2] = t; LGATE[(size_t)ex2 * 65536 + p2] = pg * w2; LRL[(size_t)ex2 * 65536 + p2] = r;
        TOKEP[(size_t)t * 2] = ((unsigned)ex1 << 16) | p1; TOKEP[(size_t)t * 2 + 1] = ((unsigned)ex2 << 16) | p2;
    }
}

DEV void moe_tables(LAS unsigned char* lds, const Params& P) {
    LAS int* T = (LAS int*)(lds + LDS_MISC);
    const unsigned* cnt = (const unsigned*)(P.ws + WS_CTL);
    __syncthreads();
    if (opaque_tid() == 0) { int ts = 0, ps = 0;
        for (int e = 0; e < 32; ++e) { const int c = (int)__hip_atomic_load(cnt + e, __ATOMIC_RELAXED, __HIP_MEMORY_SCOPE_AGENT); const int nt = (c + 255) >> 8;
            T[e] = c; T[32 + e] = ts; T[65 + e] = ps; ts += nt; ps += nt * 256; }
        T[64] = ts; T[97] = ps; }
    __syncthreads();
}

DEV void final_phase(LAS unsigned char* lds, const Params& P) {
    const int tid = opaque_tid(), lane = tid & 63, wave = tid >> 6, gw = blockIdx.x * 8 + wave, NGW = gridDim.x * 8;
    const bf16_t* H = (const bf16_t*)(P.ws + WS_H); const bf16_t* Y = (const bf16_t*)(P.ws + WS_Y); const unsigned* TOKEP = (const unsigned*)(P.ws + WS_TOKEP);
    const LAS int* pstart = (const LAS int*)(lds + LDS_MISC) + 65;
    f32x4 wv[2][2];
#pragma unroll
    for (int j = 0; j < 2; ++j) { wv[j][0] = *(const f32x4*)(P.norm_final_w + 8 * (lane + 64 * j)); wv[j][1] = *(const f32x4*)(P.norm_final_w + 8 * (lane + 64 * j) + 4); }
#define FIN_TOK(ep, t) ep = *(const u32x2*)(TOKEP + (size_t)(t) * 2)
#define FIN_LOAD(hv, yv, ep, t) do { _Pragma("unroll") for (int j = 0; j < 2; ++j) hv[j] = *(const u32x4*)(H + (size_t)(t) * DM + 8 * (lane + 64 * j)); \
        _Pragma("unroll") for (int k = 0; k < 2; ++k) { const unsigned e_ = (k ? ep.y : ep.x); const size_t slot = (size_t)pstart[e_ >> 16] + (e_ & 0xffffu); \
            _Pragma("unroll") for (int j = 0; j < 2; ++j) yv[k][j] = __builtin_nontemporal_load((const u32x4*)(Y + slot * 1024 + 8 * (lane + 64 * j))); } } while (0)
#define FIN_EMIT(hv, yv, t) do { float v[2][8]; \
        _Pragma("unroll") for (int j = 0; j < 2; ++j) _Pragma("unroll") for (int q = 0; q < 4; ++q) { \
            v[j][2 * q] = (bflo(hv[j][q]) + bflo(yv[0][j][q])) + bflo(yv[1][j][q]); v[j][2 * q + 1] = (bfhi(hv[j][q]) + bfhi(yv[0][j][q])) + bfhi(yv[1][j][q]); } \
        float s_ = 0.f; \
        _Pragma("unroll") for (int j = 0; j < 2; ++j) _Pragma("unroll") for (int q = 0; q < 8; ++q) s_ += v[j][q] * v[j][q]; \
        const float r = rsqrtf(wave_sum(s_) * (1.f / DM) + EPS); \
        _Pragma("unroll") for (int j = 0; j < 2; ++j) { float* o = P.out + (size_t)(t) * DM + 8 * (lane + 64 * j); \
            f32x4 a, c; a[0] = v[j][0] * r * wv[j][0][0]; a[1] = v[j][1] * r * wv[j][0][1]; a[2] = v[j][2] * r * wv[j][0][2]; a[3] = v[j][3] * r * wv[j][0][3]; \
            c[0] = v[j][4] * r * wv[j][1][0]; c[1] = v[j][5] * r * wv[j][1][1]; c[2] = v[j][6] * r * wv[j][1][2]; c[3] = v[j][7] * r * wv[j][1][3]; \
            __builtin_nontemporal_store(a, (f32x4*)o); __builtin_nontemporal_store(c, (f32x4*)(o + 4)); } } while (0)
    u32x2 epA = {0u, 0u}, epB = {0u, 0u}; u32x4 hA[2], hB[2], yA[2][2], yB[2][2];
    int t = gw;
    if (t < NTOK) FIN_TOK(epA, t);
    if (t + NGW < NTOK) FIN_TOK(epB, t + NGW);
    if (t < NTOK) FIN_LOAD(hA, yA, epA, t);
    while (t < NTOK) {
        const int t1 = t + NGW, t2 = t1 + NGW, t3 = t2 + NGW;
        if (t2 < NTOK) FIN_TOK(epA, t2);
        if (t1 < NTOK) FIN_LOAD(hB, yB, epB, t1);
        FIN_EMIT(hA, yA, t);
        if (t1 >= NTOK) break;
        if (t3 < NTOK) FIN_TOK(epB, t3);
        if (t2 < NTOK) FIN_LOAD(hA, yA, epA, t2);
        FIN_EMIT(hB, yB, t1);
        t = t2;
    }
#undef FIN_TOK
#undef FIN_LOAD
#undef FIN_EMIT
}


#define XB_TMO      128
#define XB_XCNT(j)  (256  + 64 * (j))
#define XB_XSUB(j)  (1280 + 64 * (j))
#define XB_XGEN(j)  (2304 + 64 * (j))
#define XB_TOP      3328
#define XB_TOPGEN   3392
#define XCD_BAR_WORDS 3456
#define XB_SPIN_CAP (1u << 18)

__device__ __forceinline__ unsigned xb_ld(unsigned* p)              { return __hip_atomic_load(p, __ATOMIC_RELAXED, __HIP_MEMORY_SCOPE_AGENT); }
__device__ __forceinline__ unsigned xb_add(unsigned* p, unsigned v) { return __hip_atomic_fetch_add(p, v, __ATOMIC_RELAXED, __HIP_MEMORY_SCOPE_AGENT); }
__device__ __forceinline__ unsigned xb_xcc_id() { return (unsigned)__builtin_amdgcn_s_getreg((3 << 11) | 20) & 0xFu; }
#define XB_SPIN(cond, bar) do { unsigned _sp = 0; while (cond) { __builtin_amdgcn_s_sleep(1); \
    if ((++_sp & 255u) == 0u) { if (xb_ld(&(bar)[XB_TMO])) break; if (_sp > XB_SPIN_CAP) { atomicAdd(&(bar)[XB_TMO], 1u); break; } } } } while (0)

struct XcdBarrier {
    unsigned* bar; unsigned x;
    volatile LAS unsigned* st;
};

__device__ __forceinline__ XcdBarrier xcd_barrier_post(unsigned* bar, volatile LAS unsigned* st) {
    XcdBarrier b; b.bar = bar; b.x = xb_xcc_id(); b.st = st;
    if (opaque_tid() == 0) (void)xb_add(&bar[XB_XCNT(b.x)], 1u);
    return b;
}
__device__ __forceinline__ void xcd_barrier_complete(unsigned* bar, unsigned x, unsigned& nloc, unsigned& nx) {
    const unsigned G = gridDim.x * gridDim.y * gridDim.z;
    unsigned sum, cnt, mine, sp = 0u;
    for (;;) {
        sum = 0u; cnt = 0u; mine = 0u;
#pragma unroll
        for (unsigned j = 0; j < 16; ++j) { const unsigned c = xb_ld(&bar[XB_XCNT(j)]); sum += c; cnt += (c > 0u) ? 1u : 0u; mine = (j == x) ? c : mine; }
        if (sum == G) break;
        __builtin_amdgcn_s_sleep(1);
        if ((++sp & 255u) == 0u) { if (xb_ld(&bar[XB_TMO])) break; if (sp > XB_SPIN_CAP) { atomicAdd(&bar[XB_TMO], 1u); break; } }
    }
    nloc = mine > 0u ? mine : 1u; nx = cnt > 0u ? cnt : 1u;
}

__device__ __forceinline__ void xcd_barrier(const XcdBarrier& b) {
    asm volatile("s_waitcnt vmcnt(0)" ::: "memory");
    __syncthreads();
    if (opaque_tid() == 0) {
        unsigned* bar = b.bar;
        __builtin_amdgcn_s_waitcnt(0);
        unsigned nloc = b.st[0], nx = b.st[1];
        if (nloc == 0u) { xcd_barrier_complete(bar, b.x, nloc, nx); b.st[0] = nloc; b.st[1] = nx; }
        const unsigned old = xb_add(&bar[XB_XSUB(b.x)], 1u);
        const unsigned gen = old / nloc;
        if (old + 1u == (gen + 1u) * nloc) {
            __builtin_amdgcn_fence(__ATOMIC_RELEASE, "agent");
            asm volatile("s_waitcnt vmcnt(0)" ::: "memory");
            const unsigned og = xb_add(&bar[XB_TOP], 1u);
            const unsigned tg = og / nx;
            if (og + 1u == (tg + 1u) * nx) xb_add(&bar[XB_TOPGEN], 1u);
            else XB_SPIN(xb_ld(&bar[XB_TOPGEN]) == tg, bar);
            __builtin_amdgcn_fence(__ATOMIC_ACQUIRE, "agent");
            xb_add(&bar[XB_XGEN(b.x)], 1u);
            asm volatile("s_waitcnt vmcnt(0)" ::: "memory");
        } else {
            XB_SPIN(xb_ld(&bar[XB_XGEN(b.x)]) == gen, bar);
            __builtin_amdgcn_fence(__ATOMIC_ACQUIRE, "agent");
            asm volatile("s_waitcnt vmcnt(0)" ::: "memory");
        }
    }
    __syncthreads();
}


DEV Params load_params() {
    const __attribute__((address_space(4))) Params* p = (const __attribute__((address_space(4))) Params*)__builtin_amdgcn_kernarg_segment_ptr();
    asm volatile("" : "+s"(p));
    Params r;
    r.x = p->x;
    r.norm_mix_w = p->norm_mix_w;
    r.w_in = p->w_in;
    r.conv_w = p->conv_w;
    r.conv_b = p->conv_b;
    r.dt_bias_f = p->dt_bias_f;
    r.dt_bias_b = p->dt_bias_b;
    r.a_log_f = p->a_log_f;
    r.a_log_b = p->a_log_b;
    r.ssd_d = p->ssd_d;
    r.ssd_norm_w = p->ssd_norm_w;
    r.lq1 = p->lq1;
    r.lk1 = p->lk1;
    r.lq2 = p->lq2;
    r.lk2 = p->lk2;
    r.subln_w = p->subln_w;
    r.w_out = p->w_out;
    r.norm_ffn_w = p->norm_ffn_w;
    r.w_rg = p->w_rg;
    r.b_rg = p->b_rg;
    r.w_re = p->w_re;
    r.b_re = p->b_re;
    r.w_gate = p->w_gate;
    r.w_up = p->w_up;
    r.w_down = p->w_down;
    r.norm_final_w = p->norm_final_w;
    r.out = p->out;
    r.ws = p->ws;
    return r;
}

__global__ void __launch_bounds__(512, 2) hymba_fwd(Params Pk) {
    extern __shared__ __attribute__((aligned(16))) unsigned char lds_raw[];
    LAS unsigned char* lds = (LAS unsigned char*)lds_raw;
    cg::grid_group grid = cg::this_grid();
    const int G = gridDim.x, c = blockIdx.x;
    { volatile LAS unsigned* st = (volatile LAS unsigned*)(lds + LDS_BYTES - 16);
      if (threadIdx.x < 4) st[threadIdx.x] = 0u;
      if ((threadIdx.x & 63) == 0) *(LAS int*)(lds + LDS_WTAB + 4 * hw_wave_slot()) = (int)(threadIdx.x >> 6);
      __syncthreads(); }
    XcdBarrier xbar;
    { const Params P = load_params();
      if (P.ws == nullptr) grid.sync();
      xbar = xcd_barrier_post((unsigned*)(P.ws + WS_CTL) + 1024, (volatile LAS unsigned*)(lds + LDS_BYTES - 16)); }
#define GRID_SYNC() xcd_barrier(xbar)

    { const Params P = load_params(); p0_phase(P, lds); }
    GRID_SYNC();
    { const Params P = load_params();
      g8::SchedInProj S{(const char*)(P.ws + WS_U), (const char*)(P.ws + WS_WIN), G, c};
      g8::EpiInProj E{(bf16_t*)(P.ws + WS_Z), (bf16_t*)(P.ws + WS_XBC), (bf16_t*)(P.ws + WS_Q), (bf16_t*)(P.ws + WS_K), (bf16_t*)(P.ws + WS_VT), (float*)(P.ws + WS_DT)};
      g8::gemm_phase(lds, 1024, S, E); }
    GRID_SYNC();
    { const Params P = load_params(); ssd::state_phase(lds, P); }
    GRID_SYNC();
    { const Params P = load_params(); ssd::scan_phase(P); }
    GRID_SYNC();
    { const Params P = load_params(); att::attn_phase(lds, P); }
    { const Params P = load_params(); ssd::out_phase(lds, P); }
    GRID_SYNC();
    { const Params P = load_params();
      g8::SchedOutProj S{(const char*)(P.ws + WS_MIX), (const char*)(P.ws + WS_WOUT), (const float*)(P.ws + WS_RLS), G, c};
      g8::EpiOutProj E{P.x, (bf16_t*)(P.ws + WS_H), (float*)(P.ws + WS_RSS)};
      g8::gemm_phase(lds, 1024, S, E); }
    GRID_SYNC();
    { const Params P = load_params();
      g8::SchedRouter S{(const char*)(P.ws + WS_H), (const char*)(P.ws + WS_WR), G, c};
      g8::EpiRouter E{(float*)(P.ws + WS_LOG)};
      g8::gemm_phase(lds, 1024, S, E); }
    GRID_SYNC();
    { const Params P = load_params(); route_phase(lds, P); }
    GRID_SYNC();
    { const Params P = load_params(); moe_tables(lds, P); }
    { const Params P = load_params();
      const LAS int* T = (const LAS int*)(lds + LDS_MISC);
      g8::MoeTables MT{T, T + 32, T + 65};
      g8::SchedMoe1 S{(const char*)(P.ws + WS_H), (const char*)(P.ws + WS_WGU), (const int*)(P.ws + WS_LTOK), MT, G, c};
      g8::EpiMoe1 E{(bf16_t*)(P.ws + WS_HDN), (const float*)(P.ws + WS_LRL), (const float*)(P.ws + WS_LGATE)};
      g8::gemm_phase(lds, 1024, S, E);
      GRID_SYNC(); }
    { const Params P = load_params();
      const LAS int* T = (const LAS int*)(lds + LDS_MISC);
      g8::MoeTables MT{T, T + 32, T + 65};
      g8::SchedMoe2 S2{(const char*)(P.ws + WS_HDN), (const char*)(P.ws + WS_WD), MT, G, c};
      g8::EpiMoe2 E2{(bf16_t*)(P.ws + WS_Y)};
      g8::gemm_phase(lds, 512, S2, E2); }
    GRID_SYNC();
    { const Params P = load_params(); final_phase(lds, P); }
}

extern "C" void kernel_launch(void* const* d_in, const int* in_sizes, int n_in, void* d_out, int out_size, void* d_ws, size_t ws_size, hipStream_t stream) {
    static int grid = 0;
    if (grid == 0) {
        if (n_in != 26 || out_size != NTOK * DM || ws_size < WS_END) { fprintf(stderr, "kernel_launch: unexpected problem (n_in %d, out %d, ws %zu); nothing launched\n", n_in, out_size, ws_size); grid = -1; return; }
        int dev = 0, cus = 0, per_cu = 0;
        hipGetDevice(&dev); hipDeviceGetAttribute(&cus, hipDeviceAttributeMultiprocessorCount, dev);
        if (hipFuncSetAttribute((const void*)hymba_fwd, hipFuncAttributeMaxDynamicSharedMemorySize, LDS_BYTES) != hipSuccess) { fprintf(stderr, "kernel_launch: hipFuncSetAttribute failed\n"); grid = -1; return; }
        if (hipOccupancyMaxActiveBlocksPerMultiprocessor(&per_cu, (const void*)hymba_fwd, 512, LDS_BYTES) != hipSuccess || per_cu < 1) { fprintf(stderr, "kernel_launch: occupancy query says %d blocks per CU\n", per_cu); grid = -1; (void)hipGetLastError(); return; }
        grid = cus;
    }
    if (grid < 0) return;
    hipMemsetAsync((char*)d_ws + WS_CTL, 0, CTL_ZERO_BYTES, stream);
    Params p{};
    const float** pp = (const float**)&p;
    for (int i = 0; i < 26; ++i) pp[i] = (const float*)d_in[i];
    p.out = (float*)d_out; p.ws = (unsigned char*)d_ws;
    void* args[] = {&p};
    hipError_t e = hipLaunchCooperativeKernel((const void*)hymba_fwd, dim3(grid), dim3(512), args, LDS_BYTES, stream);
    if (e != hipSuccess) fprintf(stderr, "kernel_launch: cooperative launch failed: %s (grid %d)\n", hipGetErrorString(e), grid);
}
```

```cpp
#include <hip/hip_runtime.h>
#include <hip/hip_cooperative_groups.h>
#include <cstdio>
#include <cstdint>
namespace cg = cooperative_groups;


#define LAS __attribute__((address_space(3)))
#define DEV __device__ __forceinline__
typedef unsigned short bf16_t;
typedef short bf16x8 __attribute__((ext_vector_type(8)));
typedef float f32x4 __attribute__((ext_vector_type(4)));
typedef float f32x16 __attribute__((ext_vector_type(16)));
typedef unsigned u32x4 __attribute__((ext_vector_type(4)));
typedef unsigned u32x2 __attribute__((ext_vector_type(2)));

constexpr int NTOK = 65536, DM = 1024, SEQ = 4096, NBATCH = 16, NCHUNK = 32;
constexpr float EPS = 1e-6f;
constexpr float LOG2E = 1.4426950408889634f;
constexpr float QSCALE = 0.125f * 1.4426950408889634f;
constexpr float LAMBDA_INIT = 0.2f;

constexpr size_t MiB = 1ull << 20;
constexpr size_t WS_CTL = 0, CTL_ZERO_BYTES = 32768;
constexpr size_t WS_LTOK = 1 * MiB, WS_LGATE = 9 * MiB, WS_LRL = 17 * MiB, WS_TOKEP = 25 * MiB, WS_CD = 26 * MiB, WS_RSS = 27 * MiB, WS_WR = 31 * MiB;
constexpr size_t WS_WIN = 32 * MiB, WS_WOUT = 40 * MiB, WS_WGU = 48 * MiB, WS_WD = 112 * MiB;
constexpr size_t WS_U = 144 * MiB, WS_XBC = 272 * MiB, WS_Z = 400 * MiB, WS_Q = 464 * MiB, WS_K = 528 * MiB, WS_VT = 592 * MiB, WS_DT = 656 * MiB, WS_ST = 664 * MiB, WS_MIX = 792 * MiB;
constexpr size_t WS_XCX = 176 * MiB, WS_XCBC = 920 * MiB;
constexpr size_t WS_DTT = 240 * MiB;
constexpr size_t WS_RLS = 31 * MiB + 512 * 1024;
constexpr size_t WS_H = 464 * MiB, WS_HDN = 272 * MiB, WS_Y = 592 * MiB, WS_LOG = 144 * MiB, WS_END = 984 * MiB;

constexpr int LDS_BYTES = 163840;
constexpr int LDS_MISC = 131072;

struct Params {
    const float* x; const float* norm_mix_w; const float* w_in; const float* conv_w; const float* conv_b;
    const float* dt_bias_f; const float* dt_bias_b; const float* a_log_f; const float* a_log_b; const float* ssd_d; const float* ssd_norm_w;
    const float* lq1; const float* lk1; const float* lq2; const float* lk2; const float* subln_w; const float* w_out; const float* norm_ffn_w;
    const float* w_rg; const float* b_rg; const float* w_re; const float* b_re; const float* w_gate; const float* w_up; const float* w_down; const float* norm_final_w;
    float* out; unsigned char* ws;
};

typedef float f32x2_t __attribute__((ext_vector_type(2)));
typedef __bf16 bf16x2_t __attribute__((ext_vector_type(2)));
DEV unsigned pk_bf16(float lo, float hi) { const f32x2_t v = {lo, hi}; const bf16x2_t b = __builtin_convertvector(v, bf16x2_t); return __builtin_bit_cast(unsigned, b); }
DEV float bflo(unsigned u) { return __uint_as_float(u << 16); }
DEV float bfhi(unsigned u) { return __uint_as_float(u & 0xffff0000u); }
template <int O> DEV float xor_other(float v) {
    return __int_as_float(__builtin_amdgcn_ds_swizzle(__float_as_int(v), (O << 10) | 0x1f)); }
DEV float sum_xor32(float v) { const auto rr = __builtin_amdgcn_permlane32_swap(__float_as_uint(v), __float_as_uint(v), false, false); return __uint_as_float(rr[0]) + __uint_as_float(rr[1]); }
DEV float wave_sum(float v) {
    v += xor_other<1>(v); v += xor_other<2>(v); v += xor_other<4>(v); v += xor_other<8>(v); v += xor_other<16>(v);
    return sum_xor32(v);
}
DEV float fast_exp2(float v) { return __builtin_amdgcn_exp2f(v); }
DEV float fadd_s(float a, float b) { float r; asm volatile("v_add_f32_e32 %0, %1, %2" : "=v"(r) : "v"(a), "v"(b)); return r; }
DEV float ffma_sk(float k, float a, float b) { float r; asm("v_fma_f32 %0, %1, %2, %3" : "=v"(r) : "s"(k), "v"(a), "v"(b)); return r; }
DEV float fast_rcp(float v) { return __builtin_amdgcn_rcpf(v); }
DEV float silu_f(float v) { return v * fast_rcp(1.f + fast_exp2(-v * LOG2E)); }
#define LDS_WAIT() asm volatile("s_waitcnt lgkmcnt(0)" ::: "memory")
constexpr int LDS_WTAB = LDS_BYTES - 16 - 256;
DEV int hw_wave_slot() { return (int)__builtin_amdgcn_s_getreg((5 << 11) | 4) & 63; }
DEV int opaque_tid() {
    extern __shared__ __attribute__((aligned(16))) unsigned char lds_raw[];
    const int wave = __builtin_amdgcn_readfirstlane(*(const LAS int*)((LAS unsigned char*)lds_raw + LDS_WTAB + 4 * hw_wave_slot()));
    int t = wave * 64 + (int)__builtin_amdgcn_mbcnt_hi(~0u, __builtin_amdgcn_mbcnt_lo(~0u, 0u));
    asm volatile("" : "+v"(t)); return t; }

struct P0Item { const float* colptr; size_t ldn; const float* kscale; bf16_t* dst; int k0, Kd, n0, nt; };
DEV void p0_load(const P0Item& I, float (&v)[32], f32x4 (&sc)[2], int lane) {
#pragma unroll
    for (int i = 0; i < 32; ++i) { const int kk = 2 * i + (lane >> 5); v[i] = I.colptr ? __builtin_nontemporal_load(I.colptr + (size_t)(I.k0 + kk) * I.ldn) : 0.f; }
    const int c = lane & 7;
    if (I.kscale) { sc[0] = *(const f32x4*)(I.kscale + I.k0 + 8 * c); sc[1] = *(const f32x4*)(I.kscale + I.k0 + 8 * c + 4); }
    else { sc[0] = (f32x4){1.f, 1.f, 1.f, 1.f}; sc[1] = sc[0]; }
}
DEV void p0_emit(const P0Item& I, const float (&v)[32], const f32x4 (&sc)[2], LAS float* scr, int lane) {
#pragma unroll
    for (int i = 0; i < 32; ++i) { const int kk = 2 * i + (lane >> 5); scr[kk * 33 + (lane & 31)] = v[i]; }
    LDS_WAIT();
    const int c = lane & 7;
#pragma unroll
    for (int j = 0; j < 4; ++j) {
        const int n = (lane >> 3) + 8 * j; const LAS float* s = scr + (8 * c) * 33 + n;
        u32x4 o; o.x = pk_bf16(s[0 * 33] * sc[0][0], s[1 * 33] * sc[0][1]); o.y = pk_bf16(s[2 * 33] * sc[0][2], s[3 * 33] * sc[0][3]);
        o.z = pk_bf16(s[4 * 33] * sc[1][0], s[5 * 33] * sc[1][1]); o.w = pk_bf16(s[6 * 33] * sc[1][2], s[7 * 33] * sc[1][3]);
        u32x4* op_ = (u32x4*)(I.dst + (size_t)(I.n0 + n) * I.Kd + I.k0 + 8 * c);
        if (I.nt) __builtin_nontemporal_store(o, op_); else *op_ = o;
    }
    LDS_WAIT();
}
DEV P0Item p0_decode(const Params& P, int it, int l31) {
    bf16_t* WIN = (bf16_t*)(P.ws + WS_WIN); bf16_t* WOUT = (bf16_t*)(P.ws + WS_WOUT); bf16_t* WGU = (bf16_t*)(P.ws + WS_WGU); bf16_t* WD = (bf16_t*)(P.ws + WS_WD); bf16_t* WR = (bf16_t*)(P.ws + WS_WR);
    constexpr int I_IN = 16 * 104, I_OUT = 16 * 32, I_GU = 32 * 512, I_D = 32 * 256;
    P0Item I;
    if (it < I_IN) {
        const int kb = it / 104, nb = it % 104, np = 32 * nb + l31;
        const int col = np < 1536 ? np : (np < 3072 ? np + 16 : (np < 3088 ? np - 1536 : -1));
        I.colptr = col >= 0 ? P.w_in + col : nullptr; I.ldn = 3088; I.k0 = 64 * kb; I.kscale = nullptr; I.dst = WIN; I.Kd = 1024; I.n0 = 32 * nb; I.nt = 0; return I; }
    it -= I_IN;
    if (it < I_OUT) { const int kb = it / 32, nb = it % 32; I.colptr = P.w_out + 32 * nb + l31; I.ldn = 1024; I.k0 = 64 * kb; I.kscale = nullptr; I.dst = WOUT; I.Kd = 1024; I.n0 = 32 * nb; I.nt = 1; return I; }
    it -= I_OUT;
    if (it < I_GU) {
        const int e = it / 512, r = it % 512, kb = r / 32, nb = r % 32, np = 32 * nb + l31, bj = (np >> 7) & 1, col = 128 * (np >> 8) + (np & 127);
        I.colptr = (bj ? P.w_up : P.w_gate) + (size_t)e * 1024 * 512 + col; I.ldn = 512; I.k0 = 64 * kb; I.kscale = P.norm_ffn_w; I.dst = WGU + (size_t)e * 1024 * 1024; I.Kd = 1024; I.n0 = 32 * nb; I.nt = 1; return I; }
    it -= I_GU;
    if (it < I_D) { const int e = it / 256, r = it % 256, kb = r / 32, nb = r % 32;
        const int csrc = (nb >> 3) * 256 + 64 * (nb & 3) + 32 * ((nb >> 2) & 1);
        I.colptr = P.w_down + (size_t)e * 512 * 1024 + csrc + l31; I.ldn = 1024; I.k0 = 64 * kb; I.kscale = nullptr; I.dst = WD + (size_t)e * 1024 * 512; I.Kd = 512; I.n0 = 32 * nb; I.nt = 1; return I; }
    it -= I_D;
    { const int kb = it / 8, nb = it % 8, np = 32 * nb + l31;
      I.colptr = np < 4 ? P.w_rg + np : (np < 36 ? P.w_re + (np - 4) : nullptr); I.ldn = np < 4 ? 4 : 32; I.k0 = 64 * kb; I.kscale = P.norm_ffn_w; I.dst = WR; I.Kd = 1024; I.n0 = 32 * nb; I.nt = 1; return I; }
}

DEV void p0_phase(const Params& P, LAS unsigned char* lds) {
    const int tid = opaque_tid(), lane = tid & 63, wave = tid >> 6;
    LAS float* scr = (LAS float*)(lds + wave * 16384);
    const int gw = blockIdx.x * 8 + wave, NGW = gridDim.x * 8;
    constexpr int NITEMS = 16 * 104 + 16 * 32 + 32 * 512 + 32 * 256 + 16 * 8;
    {
        const int l31 = lane & 31;
        float va[32], vb[32]; f32x4 sa[2], sb[2]; P0Item cur, nxt;
        int it = gw;
        if (it < NITEMS) { cur = p0_decode(P, it, l31); p0_load(cur, va, sa, lane); }
        while (it < NITEMS) {
            int itn = it + NGW;
            if (itn < NITEMS) { nxt = p0_decode(P, itn, l31); p0_load(nxt, vb, sb, lane); }
            p0_emit(cur, va, sa, scr, lane);
            it = itn; if (it >= NITEMS) break;
            itn = it + NGW;
            if (itn < NITEMS) { cur = p0_decode(P, itn, l31); p0_load(cur, va, sa, lane); }
            p0_emit(nxt, vb, sb, scr, lane);
            it = itn;
        }
    }
    bf16_t* U = (bf16_t*)(P.ws + WS_U);
    f32x4 wv[4];
#pragma unroll
    for (int j = 0; j < 4; ++j) wv[j] = ((const f32x4*)P.norm_mix_w)[lane + 64 * j];
#define P0_XLOAD(v, m) do { _Pragma("unroll") for (int q = 0; q < 2; ++q) { const f32x4* xr = (const f32x4*)(P.x + (size_t)((m) + q) * DM) + lane; \
        _Pragma("unroll") for (int j = 0; j < 4; ++j) v[q][j] = __builtin_nontemporal_load(xr + 64 * j); } } while (0)
#define P0_XEMIT(v, m) do { _Pragma("unroll") for (int q = 0; q < 2; ++q) { float ss = 0.f; \
        _Pragma("unroll") for (int j = 0; j < 4; ++j) ss += (v[q][j].x * v[q][j].x + v[q][j].y * v[q][j].y) + (v[q][j].z * v[q][j].z + v[q][j].w * v[q][j].w); \
        const float r = rsqrtf(wave_sum(ss) * (1.f / DM) + EPS); \
        u32x2* o = (u32x2*)(U + (size_t)((m) + q) * DM) + lane; \
        _Pragma("unroll") for (int j = 0; j < 4; ++j) { u32x2 w; w.x = pk_bf16(v[q][j].x * r * wv[j].x, v[q][j].y * r * wv[j].y); w.y = pk_bf16(v[q][j].z * r * wv[j].z, v[q][j].w * r * wv[j].w); o[64 * j] = w; } } } while (0)
    {
        f32x4 xa[2][4], xb[2][4];
        int m0 = 2 * gw; const int step = 2 * NGW;
        if (m0 < NTOK) P0_XLOAD(xa, m0);
        while (m0 < NTOK) {
            int m1 = m0 + step;
            if (m1 < NTOK) P0_XLOAD(xb, m1);
            P0_XEMIT(xa, m0);
            m0 = m1; if (m0 >= NTOK) break;
            m1 = m0 + step;
            if (m1 < NTOK) P0_XLOAD(xa, m1);
            P0_XEMIT(xb, m0);
            m0 = m1;
        }
    }
#undef P0_XLOAD
#undef P0_XEMIT
}

namespace g8 {
constexpr int HTB = 128 * 64 * 2;
DEV int lds_byte(int r, int c) { const int st = (r >> 4) * 2 + (c >> 5), rr = r & 15, cc = c & 31, ob = rr * 64 + cc * 2; return st * 1024 + (ob ^ (((ob >> 9) & 1) << 5)); }
DEV void stage_rc(int b, int& R, int& C) { const int st = b / 1024, sb = b % 1024, swz = sb ^ (((sb >> 9) & 1) << 5); R = (st >> 1) * 16 + swz / 64; C = (st & 1) * 32 + (swz % 64) / 2; }
DEV int perm32(int rho) { const int n = rho >> 4, i = rho & 15; return 8 * (i >> 2) + 4 * n + (i & 3); }

struct GUnit { const char* a; const char* b; int pm, pn, e, kind, cnt, ps; };

template <class Epi, class Sched>
DEV void gemm_phase(LAS unsigned char* lds, const int K, const Sched& S, const Epi& E) {
    int tid_ = opaque_tid();
    const int tid = tid_, wid = __builtin_amdgcn_readfirstlane(tid >> 6), lane = tid & 63, wr = wid >> 2, wc = wid & 3, fr = lane & 15, fq = lane >> 4;
    const int nt = K / 64;
    int Rr[2], Cc[2]; unsigned voffB[2];
#pragma unroll
    for (int i = 0; i < 2; ++i) { stage_rc(tid * 16 + i * 8192, Rr[i], Cc[i]); const int Rb = (Rr[i] & ~31) + perm32(Rr[i] & 31); voffB[i] = (unsigned)(Rb * K + Cc[i]) * 2u; }
    const size_t kstep = 128; const size_t hstepB = (size_t)128 * K * 2;
    const unsigned ldsw = (unsigned)wid * 1024u;
    const int aoff = lds_byte(wr * 64 + fr, fq * 8), boff = lds_byte(wc * 32 + fr, fq * 8);
#define G8_SA(b, h) (((b) * 2 + (h)) * HTB)
#define G8_SB(b, h) ((4 + (b) * 2 + (h)) * HTB)
#define G8_STAGE(bufoff, gbase, voff) do { _Pragma("unroll") for (int _i = 0; _i < 2; ++_i) \
        __builtin_amdgcn_global_load_lds((const unsigned*)((const char*)(gbase) + (voff)[_i]), (LAS unsigned*)(lds + (bufoff) + ldsw + _i * 8192), 16, 0, 0); } while (0)
#define G8_LDA(dst, b, h) do { _Pragma("unroll") for (int m = 0; m < 4; ++m) _Pragma("unroll") for (int k = 0; k < 2; ++k) dst[m][k] = *(const LAS bf16x8*)(lds + G8_SA(b, h) + aoff + m * 2048 + k * 1024); } while (0)
#define G8_LDB(dst, b, h) do { _Pragma("unroll") for (int n = 0; n < 2; ++n) _Pragma("unroll") for (int k = 0; k < 2; ++k) dst[n][k] = *(const LAS bf16x8*)(lds + G8_SB(b, h) + boff + n * 2048 + k * 1024); } while (0)
#define G8_MMA(ai, bj, At, Bt) do { __builtin_amdgcn_s_setprio(1); _Pragma("unroll") for (int m = 0; m < 4; ++m) _Pragma("unroll") for (int n = 0; n < 2; ++n) _Pragma("unroll") for (int k = 0; k < 2; ++k) \
        acc[ai][bj][m][n] = __builtin_amdgcn_mfma_f32_16x16x32_bf16(Bt[n][k], At[m][k], acc[ai][bj][m][n], 0, 0, 0); __builtin_amdgcn_s_setprio(0); } while (0)
#define G8_WAIT_V(n) asm volatile("s_waitcnt vmcnt(" #n ")" ::: "memory")
#define G8_WAIT_L(n) asm volatile("s_waitcnt lgkmcnt(" #n ")" ::: "memory")
#define G8_BAR __builtin_amdgcn_s_barrier()
#define G8_SCHED __builtin_amdgcn_sched_barrier(0)
    GUnit cur, nxt; int ui = 0;
    if (!S.next(0, cur)) return;
    unsigned voA[2][2], nvoA[2][2];
    S.aoff(cur, Rr, Cc, voA);
    f32x4 acc[2][2][4][2];
#pragma unroll
    for (int a = 0; a < 2; ++a)
#pragma unroll
        for (int b = 0; b < 2; ++b)
#pragma unroll
            for (int m = 0; m < 4; ++m)
#pragma unroll
                for (int n = 0; n < 2; ++n) acc[a][b][m][n] = (f32x4){0.f, 0.f, 0.f, 0.f};
    bf16x8 At[4][2], B0[2][2], B1[2][2];
    const char* cA = cur.a; const char* cB = cur.b;
    G8_STAGE(G8_SB(0, 0), cB, voffB); G8_STAGE(G8_SB(0, 1), cB + hstepB, voffB); G8_STAGE(G8_SA(0, 0), cA, voA[0]); G8_STAGE(G8_SA(0, 1), cA, voA[1]);
    if (wr == 1) G8_BAR;
    G8_WAIT_V(2); G8_BAR;
    G8_STAGE(G8_SB(1, 0), cB + kstep, voffB); G8_STAGE(G8_SA(1, 0), cA + kstep, voA[0]); G8_STAGE(G8_SB(1, 1), cB + hstepB + kstep, voffB);
    G8_WAIT_V(6); G8_BAR;
    for (;;) {
        const bool has_next = S.next(ui + 1, nxt);
        const char* nA = has_next ? nxt.a : cA; const char* nB = has_next ? nxt.b : cB;
        if constexpr (Sched::GATHER) {
            if (has_next) S.aoff(nxt, Rr, Cc, nvoA);
            else {
#pragma unroll
                for (int h = 0; h < 2; ++h)
#pragma unroll
                    for (int i = 0; i < 2; ++i) nvoA[h][i] = voA[h][i];
            }
        }
        for (int t = 0; t < nt; t += 2) {
            S.mid(cur, t, acc, wr, fr);
            const bool last = (t == nt - 2);
            const char* a1 = cA + (size_t)(t + 1) * kstep;
            const char* a2 = last ? nA : cA + (size_t)(t + 2) * kstep; const char* b2 = last ? nB : cB + (size_t)(t + 2) * kstep;
            const char* a3 = a2 + kstep; const char* b3 = b2 + kstep;
            unsigned o2[2][2];
#pragma unroll
            for (int h = 0; h < 2; ++h)
#pragma unroll
                for (int i = 0; i < 2; ++i) { if constexpr (Sched::GATHER) o2[h][i] = last ? nvoA[h][i] : voA[h][i]; else o2[h][i] = voA[h][i]; }
            G8_LDB(B0, 0, 0); G8_LDB(B1, 0, 1); G8_SCHED; G8_LDA(At, 0, 0); G8_STAGE(G8_SA(1, 1), a1, voA[1]);
            G8_WAIT_V(8); G8_WAIT_L(0); G8_BAR; G8_MMA(0, 0, At, B0); G8_MMA(0, 1, At, B1); G8_BAR; G8_SCHED;
            G8_LDA(At, 0, 1); G8_STAGE(G8_SB(0, 0), b2, voffB); G8_STAGE(G8_SB(0, 1), b2 + hstepB, voffB); G8_STAGE(G8_SA(0, 0), a2, o2[0]);
            G8_WAIT_V(8); G8_WAIT_L(0); G8_BAR; G8_MMA(1, 0, At, B0); G8_MMA(1, 1, At, B1); G8_BAR; G8_SCHED;
            G8_LDB(B0, 1, 0); G8_LDB(B1, 1, 1); G8_SCHED; G8_LDA(At, 1, 0); G8_STAGE(G8_SA(0, 1), a2, o2[1]);
            G8_WAIT_V(8); G8_WAIT_L(0); G8_BAR; G8_MMA(0, 0, At, B0); G8_MMA(0, 1, At, B1); G8_BAR; G8_SCHED;
            G8_LDA(At, 1, 1); G8_STAGE(G8_SB(1, 0), b3, voffB); G8_STAGE(G8_SB(1, 1), b3 + hstepB, voffB); G8_STAGE(G8_SA(1, 0), a3, o2[0]);
            G8_WAIT_V(8); G8_WAIT_L(0); G8_BAR; G8_MMA(1, 0, At, B0); G8_MMA(1, 1, At, B1); G8_BAR; G8_SCHED;
        }
        if (wr == 0) G8_BAR;
        E(acc, cur, wr, wc, fr, fq);
        if (!has_next) break;
#pragma unroll
        for (int a = 0; a < 2; ++a)
#pragma unroll
            for (int b = 0; b < 2; ++b)
#pragma unroll
                for (int m = 0; m < 4; ++m)
#pragma unroll
                    for (int n = 0; n < 2; ++n) acc[a][b][m][n] = (f32x4){0.f, 0.f, 0.f, 0.f};
        cur = nxt; cA = nA; cB = nB; ++ui;
        if constexpr (Sched::GATHER) {
#pragma unroll
            for (int h = 0; h < 2; ++h)
#pragma unroll
                for (int i = 0; i < 2; ++i) voA[h][i] = nvoA[h][i];
        }
        if (wr == 1) G8_BAR;
    }
    G8_WAIT_V(0);
    G8_BAR;
#undef G8_SA
#undef G8_SB
#undef G8_STAGE
#undef G8_LDA
#undef G8_LDB
#undef G8_MMA
#undef G8_WAIT_V
#undef G8_WAIT_L
#undef G8_BAR
#undef G8_SCHED
}

DEV bool static_tile(int i, int G, int c, int nM, int nN, int& pm, int& pn) {
    const int nwg = nM * nN; const long L = (long)i * G + c; if (L >= nwg) return false;
    int wgid = (int)L; { const int q = nwg / 8, r = nwg % 8, xcd = wgid % 8, off = wgid / 8; wgid = (xcd < r ? xcd * (q + 1) : r * (q + 1) + (xcd - r) * q) + off; }
    const int nig = 8 * nN, gid = wgid / nig, fm = gid * 8, gsz = (nM - fm) < 8 ? (nM - fm) : 8;
    pm = fm + ((wgid % nig) % gsz); pn = (wgid % nig) / gsz; return true;
}
DEV void plain_aoff(const int* R, const int* C, int K, unsigned (&o)[2][2]) {
#pragma unroll
    for (int h = 0; h < 2; ++h)
#pragma unroll
        for (int i = 0; i < 2; ++i) o[h][i] = (unsigned)((R[i] + 128 * h) * K + C[i]) * 2u;
}

struct SchedInProj {
    static constexpr bool GATHER = false;
    const char* U; const char* W; int G, c;
    DEV bool next(int i, GUnit& u) const {
        int pm, pn; if (!static_tile(i, G, c, 256, 13, pm, pn)) return false;
        u.pm = pm; u.pn = pn; u.e = 0; u.cnt = 0; u.ps = 0;
        if (pn == 10 || pn == 11) { u.a = W + (size_t)(pn * 256) * 2048; u.b = U + (size_t)pm * 256 * 2048; u.kind = 1; }
        else { u.a = U + (size_t)pm * 256 * 2048; u.b = W + (size_t)(pn * 256) * 2048; u.kind = (pn == 12) ? 2 : 0; }
        return true;
    }
    DEV void aoff(const GUnit&, const int* R, const int* C, unsigned (&o)[2][2]) const { plain_aoff(R, C, 1024, o); }
    DEV void mid(const GUnit&, int, f32x4 (&)[2][2][4][2], int, int) const {}
};
struct EpiInProj {
    bf16_t *Z, *XBC, *Q, *Kb, *VT; float* DT;
    DEV void operator()(const f32x4 (&acc)[2][2][4][2], const GUnit& u, int wr, int wc, int fr, int fq) const {
        if (u.kind == 2) {
            if (wc == 0 && fq < 2) {
#pragma unroll
                for (int ai = 0; ai < 2; ++ai)
#pragma unroll
                    for (int m = 0; m < 4; ++m) { float* p = DT + (size_t)(u.pm * 256 + ai * 128 + wr * 64 + m * 16 + fr) * 16 + 8 * fq; *(f32x4*)p = acc[ai][0][m][0]; *(f32x4*)(p + 4) = acc[ai][0][m][1]; }
            }
            return;
        }
        bf16_t* base; size_t ldc; int rowbase, colt; float sc = 1.f;
        if (u.kind == 1) { base = VT; ldc = 65536; rowbase = (u.pn - 10) * 256; colt = u.pm * 256; }
        else {
            rowbase = u.pm * 256; const int pn = u.pn;
            if (pn < 2) { base = Z; ldc = 512; colt = pn * 256; }
            else if (pn < 6) { base = XBC; ldc = 1024; colt = (pn - 2) * 256; }
            else if (pn < 8) { base = Q; ldc = 512; colt = (pn - 6) * 256; sc = QSCALE; }
            else { base = Kb; ldc = 512; colt = (pn - 8) * 256; }
        }
        const int row0 = rowbase + wr * 64 + fr, col0 = colt + wc * 32 + 8 * fq;
        const bool far = u.pn < 2;
        if (u.kind == 1) {
            const int colp = colt + wc * 32 + 16 * (fq >> 1) + 4 * (fq & 1);
#pragma unroll
            for (int ai = 0; ai < 2; ++ai)
#pragma unroll
                for (int m = 0; m < 4; ++m) { bf16_t* rowp = base + (size_t)(row0 + ai * 128 + m * 16) * ldc + colp;
#pragma unroll
                    for (int bj = 0; bj < 2; ++bj) { const f32x4 v0 = acc[ai][bj][m][0], v1 = acc[ai][bj][m][1];
                        u32x2 w0, w1; w0.x = pk_bf16(v0[0], v0[1]); w0.y = pk_bf16(v0[2], v0[3]); w1.x = pk_bf16(v1[0], v1[1]); w1.y = pk_bf16(v1[2], v1[3]);
                        *(u32x2*)(rowp + bj * 128) = w0; *(u32x2*)(rowp + bj * 128 + 8) = w1; } }
            return;
        }
#pragma unroll
        for (int ai = 0; ai < 2; ++ai)
#pragma unroll
            for (int m = 0; m < 4; ++m) { bf16_t* rowp = base + (size_t)(row0 + ai * 128 + m * 16) * ldc + col0;
#pragma unroll
                for (int bj = 0; bj < 2; ++bj) { const f32x4 v0 = acc[ai][bj][m][0] * sc, v1 = acc[ai][bj][m][1] * sc;
                    u32x4 w; w.x = pk_bf16(v0[0], v0[1]); w.y = pk_bf16(v0[2], v0[3]); w.z = pk_bf16(v1[0], v1[1]); w.w = pk_bf16(v1[2], v1[3]);
                    if (far) __builtin_nontemporal_store(w, (u32x4*)(rowp + bj * 128)); else *(u32x4*)(rowp + bj * 128) = w; } }
    }
};

struct SchedOutProj {
    static constexpr bool GATHER = false;
    const char* A; const char* W; const float* RLS; int G, c;
    DEV bool next(int i, GUnit& u) const {
        int pm, pn; if (!static_tile(i, G, c, 256, 4, pm, pn)) return false;
        u.pm = pm; u.pn = pn; u.e = 0; u.kind = 0; u.cnt = 0; u.ps = 0; u.a = A + (size_t)pm * 256 * 2048; u.b = W + (size_t)pn * 256 * 2048; return true;
    }
    DEV void aoff(const GUnit&, const int* R, const int* C, unsigned (&o)[2][2]) const { plain_aoff(R, C, 1024, o); }
    DEV void mid(const GUnit& u, int t, f32x4 (&acc)[2][2][4][2], int wr, int fr) const {
        if (t != 8) return;
        int off = u.pm * 256 + wr * 64 + fr; asm volatile("" : "+v"(off));
        const float* rp = RLS + off;
        float rv[8];
#pragma unroll
        for (int i = 0; i < 8; ++i) rv[i] = rp[(i >> 2) * 128 + (i & 3) * 16];
#pragma unroll
        for (int ai = 0; ai < 2; ++ai)
#pragma unroll
            for (int m = 0; m < 4; ++m) {
#pragma unroll
                for (int bj = 0; bj < 2; ++bj)
#pragma unroll
                    for (int n = 0; n < 2; ++n) acc[ai][bj][m][n] = acc[ai][bj][m][n] * rv[ai * 4 + m]; }
    }
};
struct EpiOutProj {
    const float* X; bf16_t* H; float* RSS;
    DEV void operator()(const f32x4 (&acc)[2][2][4][2], const GUnit& u, int wr, int wc, int fr, int fq) const {
        const int row0 = u.pm * 256 + wr * 64 + fr, col0 = u.pn * 256 + wc * 32 + 8 * fq;
#pragma unroll
        for (int ai = 0; ai < 2; ++ai)
#pragma unroll
            for (int m = 0; m < 4; ++m) { __builtin_amdgcn_sched_barrier(0); const int row = row0 + ai * 128 + m * 16; float ss = 0.f;
#pragma unroll
                for (int bj = 0; bj < 2; ++bj) { const float* xp = X + (size_t)row * DM + col0 + bj * 128;
                    const f32x4 v0 = acc[ai][bj][m][0] + *(const f32x4*)xp, v1 = acc[ai][bj][m][1] + *(const f32x4*)(xp + 4);
                    ss += (v0[0] * v0[0] + v0[1] * v0[1]) + (v0[2] * v0[2] + v0[3] * v0[3]) + (v1[0] * v1[0] + v1[1] * v1[1]) + (v1[2] * v1[2] + v1[3] * v1[3]);
                    u32x4 w; w.x = pk_bf16(v0[0], v0[1]); w.y = pk_bf16(v0[2], v0[3]); w.z = pk_bf16(v1[0], v1[1]); w.w = pk_bf16(v1[2], v1[3]);
                    *(u32x4*)(H + (size_t)row * DM + col0 + bj * 128) = w; }
                ss += xor_other<16>(ss); ss = sum_xor32(ss);
                if (fq == 0) RSS[(size_t)row * 16 + u.pn * 4 + wc] = ss; }
    }
};

struct SchedRouter {
    static constexpr bool GATHER = false;
    const char* A; const char* W; int G, c;
    DEV bool next(int i, GUnit& u) const {
        const int L = i * G + c; if (L >= 256) return false;
        u.pm = L; u.pn = 0; u.e = 0; u.kind = 0; u.cnt = 0; u.ps = 0; u.a = A + (size_t)L * 256 * 2048; u.b = W; return true;
    }
    DEV void aoff(const GUnit&, const int* R, const int* C, unsigned (&o)[2][2]) const { plain_aoff(R, C, 1024, o); }
    DEV void mid(const GUnit&, int, f32x4 (&)[2][2][4][2], int, int) const {}
};
struct EpiRouter {
    float* LOG;
    DEV void operator()(const f32x4 (&acc)[2][2][4][2], const GUnit& u, int wr, int wc, int fr, int fq) const {
        if (wc >= 2) return;
#pragma unroll
        for (int ai = 0; ai < 2; ++ai)
#pragma unroll
            for (int m = 0; m < 4; ++m) { float* p = LOG + (size_t)(u.pm * 256 + ai * 128 + wr * 64 + m * 16 + fr) * 64 + wc * 32 + 8 * fq; *(f32x4*)p = acc[ai][0][m][0]; *(f32x4*)(p + 4) = acc[ai][0][m][1]; }
    }
};

struct MoeTables { const LAS int* cnt; const LAS int* tstart; const LAS int* pstart; };
DEV bool moe_unit(const MoeTables& T, int L, int& e, int& rt, int& pn) {
    const int total = T.tstart[32] * 4; if (L >= total) return false;
    const int rtg = L >> 2; pn = L & 3;
    int lo = 0, hi = 32;
    while (hi - lo > 1) { const int mid = (lo + hi) >> 1; if (T.tstart[mid] <= rtg) lo = mid; else hi = mid; }
    e = lo; rt = rtg - T.tstart[lo]; return true;
}
struct SchedMoe1 {
    static constexpr bool GATHER = true;
    const char* H; const char* W; const int* LTOK; MoeTables T; int G, c;
    DEV bool next(int i, GUnit& u) const {
        int e, rt, pn; if (!moe_unit(T, i * G + c, e, rt, pn)) return false;
        u.e = e; u.pm = rt; u.pn = pn; u.kind = 0; u.cnt = T.cnt[e]; u.ps = T.pstart[e]; u.a = H; u.b = W + (size_t)e * (1024 * 2048) + (size_t)pn * 256 * 2048; return true;
    }
    DEV void aoff(const GUnit& u, const int* R, const int* C, unsigned (&o)[2][2]) const {
#pragma unroll
        for (int h = 0; h < 2; ++h)
#pragma unroll
            for (int i = 0; i < 2; ++i) { const int pos = u.pm * 256 + 128 * h + R[i]; const int tok = pos < u.cnt ? LTOK[(size_t)u.e * 65536 + pos] : 0; o[h][i] = (unsigned)(tok * 1024 + C[i]) * 2u; }
    }
    DEV void mid(const GUnit&, int, f32x4 (&)[2][2][4][2], int, int) const {}
};
struct EpiMoe1 {
    bf16_t* HDN; const float* LRL; const float* LGATE;
    DEV void operator()(const f32x4 (&acc)[2][2][4][2], const GUnit& u, int wr, int wc, int fr, int fq) const {
#pragma unroll
        for (int ai = 0; ai < 2; ++ai)
#pragma unroll
            for (int m = 0; m < 4; ++m) { const int pos = u.pm * 256 + ai * 128 + wr * 64 + m * 16 + fr;
                const float r = pos < u.cnt ? LRL[(size_t)u.e * 65536 + pos] : 0.f, rg = pos < u.cnt ? r * LGATE[(size_t)u.e * 65536 + pos] : 0.f;
                float hv[8];
#pragma unroll
                for (int n = 0; n < 2; ++n)
#pragma unroll
                    for (int j = 0; j < 4; ++j) { const float g = acc[ai][0][m][n][j] * r, uu = acc[ai][1][m][n][j] * rg; hv[4 * n + j] = silu_f(g) * uu; }
                u32x4 w; w.x = pk_bf16(hv[0], hv[1]); w.y = pk_bf16(hv[2], hv[3]); w.z = pk_bf16(hv[4], hv[5]); w.w = pk_bf16(hv[6], hv[7]);
                *(u32x4*)(HDN + (size_t)(u.ps + pos) * 512 + u.pn * 128 + wc * 32 + 8 * fq) = w; }
    }
};
struct SchedMoe2 {
    static constexpr bool GATHER = false;
    const char* HDN; const char* W; MoeTables T; int G, c;
    DEV bool next(int i, GUnit& u) const {
        int e, rt, pn; if (!moe_unit(T, i * G + c, e, rt, pn)) return false;
        u.e = e; u.pm = rt; u.pn = pn; u.kind = 0; u.cnt = T.cnt[e]; u.ps = T.pstart[e];
        u.a = HDN + (size_t)(u.ps + rt * 256) * 1024; u.b = W + (size_t)e * (1024 * 1024) + (size_t)pn * 256 * 1024; return true;
    }
    DEV void aoff(const GUnit&, const int* R, const int* C, unsigned (&o)[2][2]) const { plain_aoff(R, C, 512, o); }
    DEV void mid(const GUnit&, int, f32x4 (&)[2][2][4][2], int, int) const {}
};
struct EpiMoe2 {
    bf16_t* Y;
    DEV void operator()(const f32x4 (&acc)[2][2][4][2], const GUnit& u, int wr, int wc, int fr, int fq) const {
        const int p = fr & 1;
#pragma unroll
        for (int ai = 0; ai < 2; ++ai)
#pragma unroll
            for (int m = 0; m < 4; ++m) { const int pos = u.pm * 256 + ai * 128 + wr * 64 + m * 16 + fr;
                u32x4 w[2];
#pragma unroll
                for (int bj = 0; bj < 2; ++bj) { const f32x4 v0 = acc[ai][bj][m][0], v1 = acc[ai][bj][m][1];
                    w[bj].x = pk_bf16(v0[0], v0[1]); w[bj].y = pk_bf16(v0[2], v0[3]); w[bj].z = pk_bf16(v1[0], v1[1]); w[bj].w = pk_bf16(v1[2], v1[3]); }
                u32x4 t0, t1;
#pragma unroll
                for (int q = 0; q < 4; ++q) { const unsigned offer = p ? w[0][q] : w[1][q];
                    const unsigned got = (unsigned)__builtin_amdgcn_update_dpp(0, (int)offer, 0xB1, 0xF, 0xF, false);
                    t0[q] = p ? got : w[0][q];
                    t1[q] = p ? w[1][q] : got; }
                bf16_t* rowp = Y + (size_t)(u.ps + pos - p) * 1024 + u.pn * 256 + wc * 64 + (p * 4 + fq) * 8;
                __builtin_nontemporal_store(t0, (u32x4*)rowp); __builtin_nontemporal_store(t1, (u32x4*)(rowp + 1024)); }
    }
};
}

namespace att {
constexpr int SLOT = 24576, NSLOT = 5, NT = SEQ / 64;
DEV int crow(int r, int hi) { return (r & 3) + 8 * (r >> 2) + 4 * hi; }

DEV float attn_map(LAS unsigned char* lds, const Params& P, int b, int h, int map, int qb, float cgeo, f32x16 (&o)[4]) {
    int tid_ = opaque_tid();
    const int tid = tid_, lane = tid & 63, wid = __builtin_amdgcn_readfirstlane(tid >> 6), l31 = lane & 31, hh = lane >> 5;
    const bf16_t* Q = (const bf16_t*)(P.ws + WS_Q); const bf16_t* Kg = (const bf16_t*)(P.ws + WS_K); const bf16_t* VT = (const bf16_t*)(P.ws + WS_VT);
    const unsigned* KMAX = (const unsigned*)(P.ws + WS_CTL) + 64;
    const size_t tokbase = (size_t)b * SEQ; const int Q0 = qb * 256, q0 = Q0 + wid * 32;
    bf16x8 qf[4];
    { const bf16_t* qp = Q + (tokbase + q0 + l31) * 512 + h * 128 + map * 64 + hh * 8;
#pragma unroll
      for (int ks = 0; ks < 4; ++ks) qf[ks] = *(const bf16x8*)(qp + ks * 16); }
    float s1 = 0.f;
#pragma unroll
    for (int ks = 0; ks < 4; ++ks)
#pragma unroll
        for (int j = 0; j < 8; ++j) { const float a = __uint_as_float(((unsigned)(unsigned short)qf[ks][j]) << 16); s1 += a * a; }
    s1 = sum_xor32(s1);
    const float M = sqrtf(s1 * __uint_as_float(KMAX[b * 8 + h * 2 + map])) * 1.002f + 0.02f;
    const float slope2 = exp2f(-2.f * (float)(h + 1)) * LOG2E;
    const float qpos = (float)(q0 + l31);
    LAS float* red = (LAS float*)(lds + NSLOT * SLOT);
    { float mw = M;
      mw = fmaxf(mw, xor_other<1>(mw)); mw = fmaxf(mw, xor_other<2>(mw)); mw = fmaxf(mw, xor_other<4>(mw)); mw = fmaxf(mw, xor_other<8>(mw)); mw = fmaxf(mw, xor_other<16>(mw));
      if (lane == 0) red[wid] = mw; }
    __syncthreads();
    float Mb = red[0];
#pragma unroll
    for (int w = 1; w < 8; ++w) Mb = fmaxf(Mb, red[w]);
    const int D = (int)fminf((2.f * Mb + cgeo) / slope2, 8192.f) + 1;
    const int t_lo = max(0, (Q0 - D - 63 + 63) >> 6) , t_hi = min(NT - 1, (Q0 + 255 + D) >> 6);
    const char* kbase = (const char*)(Kg + tokbase * 512 + h * 128 + map * 64);
    const char* vbase = (const char*)(VT + (size_t)(h * 128) * NTOK + tokbase);
    unsigned koff, voff;
    { const int L = tid, kv = L >> 3, cc = (L & 7) ^ ((kv >> 1) & 7); koff = (unsigned)(kv * 512 + cc * 8) * 2u; }
    { const int L = tid, d = L >> 3, cc = (L & 7) ^ ((d >> 1) & 7); voff = (unsigned)(d * NTOK + cc * 8) * 2u; }
    const unsigned ldsw = (unsigned)wid * 1024u;
#define ATT_DMA(t, sl) do { LAS unsigned char* _s = lds + (sl) * SLOT + ldsw; const char* _kb = kbase + (size_t)(t) * (64 * 512 * 2); const char* _vb = vbase + (size_t)(t) * 128; \
        __builtin_amdgcn_global_load_lds((const unsigned*)(_kb + koff), (LAS unsigned*)(_s), 16, 0, 0); \
        __builtin_amdgcn_global_load_lds((const unsigned*)(_vb + voff), (LAS unsigned*)(_s + 8192), 16, 0, 0); \
        __builtin_amdgcn_global_load_lds((const unsigned*)(_vb + (size_t)64 * NTOK * 2 + voff), (LAS unsigned*)(_s + 16384), 16, 0, 0); } while (0)
#define ATT_WAIT(k) do { if ((k) >= 3) asm volatile("s_waitcnt vmcnt(9)" ::: "memory"); else if ((k) == 2) asm volatile("s_waitcnt vmcnt(6)" ::: "memory"); else if ((k) == 1) asm volatile("s_waitcnt vmcnt(3)" ::: "memory"); else asm volatile("s_waitcnt vmcnt(0)" ::: "memory"); } while (0)
    const int swz = (l31 >> 1) & 7;
    const int rowb = l31 * 128;
#define ATT_CINIT(t, c0, c1) do { const int T_ = (t) * 64; const float dp0 = (float)(T_ + 4 * hh) - qpos; \
        if (T_ + 63 < q0) { const float bL = slope2 * dp0 - M; \
            _Pragma("unroll") for (int r = 0; r < 16; ++r) { c0[r] = fmaf(slope2, (float)((r & 3) + 8 * (r >> 2)), bL); c1[r] = fmaf(slope2, (float)(32 + (r & 3) + 8 * (r >> 2)), bL); } } \
        else if (T_ > q0 + 31) { const float bR = -slope2 * dp0 - M; \
            _Pragma("unroll") for (int r = 0; r < 16; ++r) { c0[r] = fmaf(-slope2, (float)((r & 3) + 8 * (r >> 2)), bR); c1[r] = fmaf(-slope2, (float)(32 + (r & 3) + 8 * (r >> 2)), bR); } } \
        else { _Pragma("unroll") for (int r = 0; r < 16; ++r) { c0[r] = -slope2 * fabsf(dp0 + (float)((r & 3) + 8 * (r >> 2))) - M; c1[r] = -slope2 * fabsf(dp0 + (float)(32 + (r & 3) + 8 * (r >> 2))) - M; } } } while (0)
#define ATT_QKMMA(sl, c0, c1) do { const LAS unsigned char* _kb = lds + (sl) * SLOT + rowb; \
        _Pragma("unroll") for (int ks = 0; ks < 4; ++ks) { const int _ko = ((2 * ks + hh) ^ swz) * 16; \
            const bf16x8 k0_ = *(const LAS bf16x8*)(_kb + _ko), k1_ = *(const LAS bf16x8*)(_kb + 4096 + _ko); \
            c0 = __builtin_amdgcn_mfma_f32_32x32x16_bf16(k0_, qf[ks], c0, 0, 0, 0); c1 = __builtin_amdgcn_mfma_f32_32x32x16_bf16(k1_, qf[ks], c1, 0, 0, 0); } } while (0)
#define ATT_EXP(c0, c1, pf) do { float ls0 = 0.f, ls1 = 0.f, ls2 = 0.f, ls3 = 0.f; \
        _Pragma("unroll") for (int r = 0; r < 16; r += 2) { c0[r] = fast_exp2(c0[r]); ls0 += c0[r]; c1[r] = fast_exp2(c1[r]); ls1 += c1[r]; c0[r + 1] = fast_exp2(c0[r + 1]); ls2 += c0[r + 1]; c1[r + 1] = fast_exp2(c1[r + 1]); ls3 += c1[r + 1]; } \
        lsum += (ls0 + ls1) + (ls2 + ls3); \
        _Pragma("unroll") for (int s_ = 0; s_ < 2; ++s_) { u32x4 w; w.x = pk_bf16(c0[8 * s_ + 0], c0[8 * s_ + 1]); w.y = pk_bf16(c0[8 * s_ + 2], c0[8 * s_ + 3]); w.z = pk_bf16(c0[8 * s_ + 4], c0[8 * s_ + 5]); w.w = pk_bf16(c0[8 * s_ + 6], c0[8 * s_ + 7]); pf[s_] = __builtin_bit_cast(bf16x8, w); \
            u32x4 w2; w2.x = pk_bf16(c1[8 * s_ + 0], c1[8 * s_ + 1]); w2.y = pk_bf16(c1[8 * s_ + 2], c1[8 * s_ + 3]); w2.z = pk_bf16(c1[8 * s_ + 4], c1[8 * s_ + 5]); w2.w = pk_bf16(c1[8 * s_ + 6], c1[8 * s_ + 7]); pf[2 + s_] = __builtin_bit_cast(bf16x8, w2); } } while (0)
#define ATT_SUMPACK(c0, c1, pf) do { float ls0 = 0.f, ls1 = 0.f, ls2 = 0.f, ls3 = 0.f; \
        _Pragma("unroll") for (int r = 0; r < 16; r += 2) { ls0 += c0[r]; ls1 += c1[r]; ls2 += c0[r + 1]; ls3 += c1[r + 1]; } \
        lsum += (ls0 + ls1) + (ls2 + ls3); \
        _Pragma("unroll") for (int s_ = 0; s_ < 2; ++s_) { u32x4 w; w.x = pk_bf16(c0[8 * s_ + 0], c0[8 * s_ + 1]); w.y = pk_bf16(c0[8 * s_ + 2], c0[8 * s_ + 3]); w.z = pk_bf16(c0[8 * s_ + 4], c0[8 * s_ + 5]); w.w = pk_bf16(c0[8 * s_ + 6], c0[8 * s_ + 7]); pf[s_] = __builtin_bit_cast(bf16x8, w); \
            u32x4 w2; w2.x = pk_bf16(c1[8 * s_ + 0], c1[8 * s_ + 1]); w2.y = pk_bf16(c1[8 * s_ + 2], c1[8 * s_ + 3]); w2.z = pk_bf16(c1[8 * s_ + 4], c1[8 * s_ + 5]); w2.w = pk_bf16(c1[8 * s_ + 6], c1[8 * s_ + 7]); pf[2 + s_] = __builtin_bit_cast(bf16x8, w2); } } while (0)
#define ATT_BAR() do { __builtin_amdgcn_sched_barrier(0); asm volatile("" ::: "memory"); __builtin_amdgcn_s_barrier(); asm volatile("" ::: "memory"); __builtin_amdgcn_sched_barrier(0); } while (0)
#pragma unroll
    for (int mt = 0; mt < 4; ++mt)
#pragma unroll
        for (int r = 0; r < 16; ++r) o[mt][r] = 0.f;
    float lsum = 0.f;
#define ATT_NEXT(sl) ((sl) + 1 >= NSLOT ? 0 : (sl) + 1)
#define ATT_SB() __builtin_amdgcn_sched_barrier(0)
    ATT_DMA(t_lo, 0); ATT_DMA(min(t_lo + 1, t_hi), 1); ATT_DMA(min(t_lo + 2, t_hi), 2); ATT_DMA(min(t_lo + 3, t_hi), 3);
    asm volatile("s_waitcnt vmcnt(6)" ::: "memory");
    ATT_BAR();
    f32x16 c0, c1; bf16x8 pf[4], fa[4], fb[4];
    ATT_CINIT(t_lo, c0, c1); ATT_QKMMA(0, c0, c1); ATT_EXP(c0, c1, pf);
    ATT_CINIT(t_lo + 1, c0, c1);
    { const LAS unsigned char* kb_ = lds + SLOT + rowb;
#pragma unroll
      for (int ks = 0; ks < 4; ++ks) { const int _ko = ((2 * ks + hh) ^ swz) * 16; fa[ks] = *(const LAS bf16x8*)(kb_ + _ko); fb[ks] = *(const LAS bf16x8*)(kb_ + 4096 + _ko); } }
    float ls0 = lsum, ls1 = 0.f, ls2 = 0.f, ls3 = 0.f;
    int sl = 0;
#define KF0(ks) fa[ks] = *(const LAS bf16x8*)(kb_ + (((2 * (ks) + hh) ^ swz) * 16))
#define KF1(ks) fb[ks] = *(const LAS bf16x8*)(kb_ + 4096 + (((2 * (ks) + hh) ^ swz) * 16))
#define VLD(dst, MT, S4) dst = *(const LAS bf16x8*)(vb_ + (MT) * 4096 + (((2 * (S4) + hh) ^ swz) * 16))
#define QK0(ks) c0 = __builtin_amdgcn_mfma_f32_32x32x16_bf16(fa[ks], qf[ks], c0, 0, 0, 0)
#define QK1(ks) c1 = __builtin_amdgcn_mfma_f32_32x32x16_bf16(fb[ks], qf[ks], c1, 0, 0, 0)
#define PV(MT, S4, V) o[MT] = __builtin_amdgcn_mfma_f32_32x32x16_bf16(V, pf[S4], o[MT], 0, 0, 0)
#define EX(c, R0, N) do { _Pragma("unroll") for (int r_ = 0; r_ < (N); ++r_) c[(R0) + r_] = fast_exp2(c[(R0) + r_]); } while (0)
#define SH(c, R0, LA, LB, W0, W1) do { LA = fadd_s(LA, c[R0]); LB = fadd_s(LB, c[(R0) + 1]); LA = fadd_s(LA, c[(R0) + 2]); LB = fadd_s(LB, c[(R0) + 3]); W0 = pk_bf16(c[R0], c[(R0) + 1]); W1 = pk_bf16(c[(R0) + 2], c[(R0) + 3]); } while (0)
#define PIN4(w) asm volatile("" : "+v"(w))
#define CI(c, R0, KOFF) do { _Pragma("unroll") for (int j_ = 0; j_ < 4; ++j_) c[(R0) + j_] = ffma_sk((float)((KOFF) + j_), sA, bA); } while (0)
#pragma unroll 1
    for (int t = t_lo; t < t_hi; ++t) {
        const int sl1 = ATT_NEXT(sl), sl2 = ATT_NEXT(sl1), sl4 = (sl == 0 ? NSLOT - 1 : sl - 1);
        const LAS unsigned char* vb_ = lds + sl * SLOT + 8192 + rowb;
        const LAS unsigned char* kb_ = lds + sl2 * SLOT + rowb;
        const int T2 = (t + 2) * 64, td = min(t + 4, t_hi);
        const float sA = (T2 < q0) ? slope2 : -slope2;
        const float dp2 = (float)(T2 + 4 * hh) - qpos, bA = fmaf(sA, dp2, -M);
        LAS unsigned char* ds_ = lds + sl4 * SLOT + ldsw; const char* dk_ = kbase + (size_t)td * (64 * 512 * 2); const char* dv_ = vbase + (size_t)td * 128;
        asm volatile("s_waitcnt vmcnt(3)" ::: "memory");
        ATT_BAR();
        u32x4 w;
        QK0(0); __builtin_amdgcn_global_load_lds((const unsigned*)(dk_ + koff), (LAS unsigned*)(ds_), 16, 0, 0); VLD(fa[0], 0, 0); ATT_SB();
        QK0(1); __builtin_amdgcn_global_load_lds((const unsigned*)(dv_ + voff), (LAS unsigned*)(ds_ + 8192), 16, 0, 0); VLD(fa[1], 1, 0); ATT_SB();
        QK0(2); __builtin_amdgcn_global_load_lds((const unsigned*)(dv_ + (size_t)64 * NTOK * 2 + voff), (LAS unsigned*)(ds_ + 16384), 16, 0, 0); VLD(fa[2], 2, 0); ATT_SB();
        QK0(3); VLD(fa[3], 3, 0); ATT_SB();
        QK1(0); VLD(fb[0], 0, 1); ATT_SB();
        QK1(1); VLD(fb[1], 1, 1); EX(c0, 0, 3); ATT_SB();
        QK1(2); VLD(fb[2], 2, 1); EX(c0, 3, 3); ATT_SB();
        QK1(3); VLD(fb[3], 3, 1); EX(c0, 6, 3); ATT_SB();
        PV(0, 0, fa[0]); VLD(fa[0], 0, 2); EX(c0, 9, 3); ATT_SB();
        PV(1, 0, fa[1]); VLD(fa[1], 1, 2); EX(c0, 12, 3); ATT_SB();
        PV(2, 0, fa[2]); VLD(fa[2], 2, 2); EX(c0, 15, 1); EX(c1, 0, 2); ATT_SB();
        PV(3, 0, fa[3]); VLD(fa[3], 3, 2); EX(c1, 2, 3); ATT_SB();
        PV(0, 1, fb[0]); VLD(fb[0], 0, 3); EX(c1, 5, 2); SH(c0, 0, ls0, ls1, w.x, w.y); ATT_SB();
        PV(1, 1, fb[1]); VLD(fb[1], 1, 3); EX(c1, 7, 2); SH(c0, 4, ls2, ls3, w.z, w.w); PIN4(w); pf[0] = __builtin_bit_cast(bf16x8, w); ATT_SB();
        PV(2, 1, fb[2]); VLD(fb[2], 2, 3); EX(c1, 9, 2); CI(c0, 0, 0); ATT_SB();
        PV(3, 1, fb[3]); VLD(fb[3], 3, 3); EX(c1, 11, 2); CI(c0, 4, 8); ATT_SB();
        PV(0, 2, fa[0]); KF0(0); EX(c1, 13, 2); SH(c0, 8, ls0, ls1, w.x, w.y); ATT_SB();
        PV(1, 2, fa[1]); KF0(1); EX(c1, 15, 1); SH(c0, 12, ls2, ls3, w.z, w.w); PIN4(w); pf[1] = __builtin_bit_cast(bf16x8, w); ATT_SB();
        PV(2, 2, fa[2]); KF0(2); CI(c0, 8, 16); ATT_SB();
        PV(3, 2, fa[3]); KF0(3); CI(c0, 12, 24); ATT_SB();
        PV(0, 3, fb[0]); KF1(0); SH(c1, 0, ls0, ls1, w.x, w.y); ATT_SB();
        PV(1, 3, fb[1]); KF1(1); SH(c1, 4, ls2, ls3, w.z, w.w); PIN4(w); pf[2] = __builtin_bit_cast(bf16x8, w); ATT_SB();
        PV(2, 3, fb[2]); KF1(2); CI(c1, 0, 32); CI(c1, 4, 40); ATT_SB();
        PV(3, 3, fb[3]); KF1(3); SH(c1, 8, ls0, ls1, w.x, w.y); SH(c1, 12, ls2, ls3, w.z, w.w); PIN4(w); pf[3] = __builtin_bit_cast(bf16x8, w); ATT_SB();
        CI(c1, 8, 48); CI(c1, 12, 56); ATT_SB();
        if (T2 + 63 >= q0 && T2 <= q0 + 31) {
#pragma unroll
            for (int r = 0; r < 16; ++r) { const float x0 = dp2 + (float)((r & 3) + 8 * (r >> 2)), x1 = x0 + 32.f;
                c0[r] = fmaf(-sA, x0, fmaf(-slope2, fabsf(x0), c0[r])); c1[r] = fmaf(-sA, x1, fmaf(-slope2, fabsf(x1), c1[r])); }
        }
        ATT_SB();
        sl = sl1;
    }
    lsum = (ls0 + ls1) + (ls2 + ls3);
    {
        const LAS unsigned char* vb_ = lds + sl * SLOT + 8192 + rowb;
        bf16x8 vfr[2][4];
#define ATT_VLOAD(S, MT) do { _Pragma("unroll") for (int s4 = 0; s4 < 4; ++s4) vfr[S][s4] = *(const LAS bf16x8*)(vb_ + (MT) * 4096 + (((2 * s4 + hh) ^ swz) * 16)); } while (0)
#define ATT_PV(S, MT) do { _Pragma("unroll") for (int s4 = 0; s4 < 4; ++s4) o[MT] = __builtin_amdgcn_mfma_f32_32x32x16_bf16(vfr[S][s4], pf[s4], o[MT], 0, 0, 0); } while (0)
        ATT_VLOAD(0, 0); ATT_VLOAD(1, 1); ATT_SB(); ATT_PV(0, 0); ATT_SB(); ATT_VLOAD(0, 2); ATT_SB(); ATT_PV(1, 1); ATT_SB(); ATT_VLOAD(1, 3); ATT_SB(); ATT_PV(0, 2); ATT_SB(); ATT_PV(1, 3);
        asm volatile("s_waitcnt vmcnt(0)" ::: "memory");
    }
#undef KF0
#undef KF1
#undef VLD
#undef QK0
#undef QK1
#undef PV
#undef EX
#undef SH
#undef CI
#undef PIN4
#undef ATT_NEXT
#undef ATT_VLOAD
#undef ATT_PV
#undef ATT_SB
#undef ATT_CINIT
#undef ATT_QKMMA
#undef ATT_BAR
#undef ATT_WAITX
#undef ATT_DMA
#undef ATT_WAIT
#undef ATT_QK
#undef ATT_EXP
    __syncthreads();
    lsum = sum_xor32(lsum);
    return lsum;
}

DEV void attn_unit(LAS unsigned char* lds, const Params& P, int b, int h, int qb, float lam, float cgeo) {
    int tid_ = opaque_tid();
    const int tid = tid_, lane = tid & 63, wid = __builtin_amdgcn_readfirstlane(tid >> 6), l31 = lane & 31, hh = lane >> 5;
    bf16_t* MIX = (bf16_t*)(P.ws + WS_MIX);
    const size_t tokbase = (size_t)b * SEQ; const int q0 = qb * 256 + wid * 32;
    f32x16 o[4];
    float* park = (float*)(P.ws + WS_U) + ((size_t)(blockIdx.x * 8 + wid) * 4096) + lane * 4;
    { const float l1 = attn_map(lds, P, b, h, 0, qb, cgeo, o); const float i1 = 1.f / l1;
#pragma unroll
      for (int mt = 0; mt < 4; ++mt)
#pragma unroll
          for (int g4 = 0; g4 < 4; ++g4) { f32x4 v; v[0] = o[mt][4 * g4] * i1; v[1] = o[mt][4 * g4 + 1] * i1; v[2] = o[mt][4 * g4 + 2] * i1; v[3] = o[mt][4 * g4 + 3] * i1; *(f32x4*)(park + (mt * 4 + g4) * 256) = v; } }
    const float l2 = attn_map(lds, P, b, h, 1, qb, cgeo, o);
    const float i2 = lam / l2;
    float ssq = 0.f;
#pragma unroll
    for (int mt = 0; mt < 4; ++mt) {
        __builtin_amdgcn_sched_barrier(0);
#pragma unroll
        for (int g4 = 0; g4 < 4; ++g4) { const f32x4 a = *(const f32x4*)(park + (mt * 4 + g4) * 256);
#pragma unroll
            for (int e = 0; e < 4; ++e) { const float v = a[e] - o[mt][4 * g4 + e] * i2; o[mt][4 * g4 + e] = v; ssq += v * v; } }
    }
    __builtin_amdgcn_sched_barrier(0);
    ssq = sum_xor32(ssq);
    const float rs = rsqrtf(ssq * (1.f / 128.f) + EPS) * (1.f - LAMBDA_INIT);
    LAS unsigned char* stg = lds + wid * 8704;
#pragma unroll
    for (int mt = 0; mt < 4; ++mt)
#pragma unroll
        for (int g4 = 0; g4 < 4; ++g4) { const int d0 = 32 * mt + 8 * g4 + 4 * hh; const f32x4 sw = *(const f32x4*)(P.subln_w + d0);
            u32x2 w; w.x = pk_bf16(o[mt][4 * g4 + 0] * rs * sw[0], o[mt][4 * g4 + 1] * rs * sw[1]); w.y = pk_bf16(o[mt][4 * g4 + 2] * rs * sw[2], o[mt][4 * g4 + 3] * rs * sw[3]);
            *(LAS u32x2*)(stg + l31 * 272 + d0 * 2) = w; }
    LDS_WAIT();
#pragma unroll
    for (int i = 0; i < 8; ++i) { const int row = i * 4 + (lane >> 4), ck = lane & 15;
        const u32x4 v = *(const LAS u32x4*)(stg + row * 272 + ck * 16);
        *(u32x4*)(MIX + (tokbase + q0 + row) * DM + 512 + h * 128 + ck * 8) = v; }
    __syncthreads();
}

DEV void attn_phase(LAS unsigned char* lds, const Params& P) {
    const int lane = opaque_tid() & 63;
    const float d1 = wave_sum(P.lq1[lane] * P.lk1[lane]), d2 = wave_sum(P.lq2[lane] * P.lk2[lane]);
    const float lam = expf(d1) - expf(d2) + LAMBDA_INIT;
    for (int u0 = blockIdx.x; u0 < NBATCH * 16; u0 += gridDim.x) {
        const int x = u0 & 7, idx = u0 >> 3, b = 2 * x + (idx >> 4), qb = idx & 15;
#pragma unroll 1
        for (int h = 0; h < 4; ++h) { const float sl2 = exp2f(-2.f * (float)(h + 1)) * LOG2E;
            attn_unit(lds, P, b, h, qb, lam, 29.f + log2f(1.f / (1.f - exp2f(-sl2)))); }
    }
}
}

namespace ssd {
constexpr int PITCH = 272;
DEV int crow(int r, int hi) { return (r & 3) + 8 * (r >> 2) + 4 * hi; }
DEV float softplus_f(float v) { return v > 15.f ? v : 0.6931471805599453f * __builtin_amdgcn_logf(1.f + fast_exp2(v * LOG2E)); }

DEV void conv8x8(const bf16_t* XBC, int b, int t0, int ch0, const float* cw, const float* cb, u32x4 (&outp)[8]) {
    u32x4 rows[12];
#pragma unroll
    for (int i = 0; i < 12; ++i) { const int t = t0 - 2 + i; u32x4 z = {0u, 0u, 0u, 0u};
        rows[i] = (t >= 0 && t < SEQ) ? *(const u32x4*)(XBC + ((size_t)b * SEQ + t) * 1024 + ch0) : z; }
#pragma unroll
    for (int q = 0; q < 4; ++q) {
        float i0[12], i1[12];
#pragma unroll
        for (int i = 0; i < 12; ++i) { const unsigned u = rows[i][q]; i0[i] = bflo(u); i1[i] = bfhi(u); }
        float w0[5], w1[5];
#pragma unroll
        for (int j = 0; j < 5; ++j) { const float2 w = *(const float2*)(cw + j * 1024 + ch0 + 2 * q); w0[j] = w.x; w1[j] = w.y; }
        const float2 bb = *(const float2*)(cb + ch0 + 2 * q); const float b0 = bb.x, b1 = bb.y;
#pragma unroll
        for (int tk = 0; tk < 8; ++tk) { float a0 = b0, a1 = b1;
#pragma unroll
            for (int j = 0; j < 5; ++j) { a0 += w0[j] * i0[tk + j]; a1 += w1[j] * i1[tk + j]; }
            outp[tk][q] = pk_bf16(silu_f(a0), silu_f(a1)); }
    }
}
template <bool WGT> DEV u32x4 tr_chan(const u32x4 (&outp)[8], int k, const float (&wgt)[8]) {
    float v[8];
#pragma unroll
    for (int tk = 0; tk < 8; ++tk) { const unsigned u = outp[tk][k >> 1]; v[tk] = (k & 1) ? bfhi(u) : bflo(u); if (WGT) v[tk] *= wgt[tk]; }
    u32x4 w; w.x = pk_bf16(v[0], v[1]); w.y = pk_bf16(v[2], v[3]); w.z = pk_bf16(v[4], v[5]); w.w = pk_bf16(v[6], v[7]); return w;
}

DEV void dt_tables(const Params& P, LAS float* A1, LAS float* A2, LAS float* A3, LAS float* A4, int tok0, int g) {
    int tid_ = opaque_tid();
    const int tid = tid_, lane = tid & 63, wid = tid >> 6;
    const float* DT = (const float*)(P.ws + WS_DT);
    {
        const int t = tid & 127, r = tid >> 7, hd = 4 * g + r;
        const float dtf = softplus_f(DT[(size_t)(tok0 + t) * 16 + hd] + P.dt_bias_f[hd]), dtb = softplus_f(DT[(size_t)(tok0 + t) * 16 + 8 + hd] + P.dt_bias_b[hd]);
        A1[r * 128 + t] = -dtf * fast_exp2(P.a_log_f[hd] * LOG2E) * LOG2E; A2[r * 128 + t] = -dtb * fast_exp2(P.a_log_b[hd] * LOG2E) * LOG2E;
        A3[r * 128 + t] = __builtin_amdgcn_logf(dtf); A4[r * 128 + t] = __builtin_amdgcn_logf(dtb);
    }
    __syncthreads();
    {
        const int r = wid & 3, dir = wid >> 2; LAS float* arr = (dir ? A2 : A1) + r * 128; LAS float* qa = (dir ? A4 : A3) + r * 128;
        const float v0 = arr[2 * lane], v1 = arr[2 * lane + 1], pair = v0 + v1; float incl = pair;
#pragma unroll
        for (int o = 1; o < 64; o <<= 1) { const float n = __int_as_float(__builtin_amdgcn_ds_bpermute((lane - o) << 2, __float_as_int(incl))); if (lane >= o) incl += n; }
        float o0, o1;
        if (dir == 0) { o0 = incl - v1; o1 = incl; }
        else { const float tot = __int_as_float(__builtin_amdgcn_readlane(__float_as_int(incl), 63)); o0 = tot - (incl - pair); o1 = tot - (incl - v1); }
        const float l0 = qa[2 * lane], l1 = qa[2 * lane + 1];
        arr[2 * lane] = o0; arr[2 * lane + 1] = o1; qa[2 * lane] = o0 - l0; qa[2 * lane + 1] = o1 - l1;
    }
    __syncthreads();
}

DEV void state_unit(LAS unsigned char* lds, const Params& P, int b, int c, int g) {
    int tid_ = opaque_tid();
    const int tid = tid_, lane = tid & 63, wid = __builtin_amdgcn_readfirstlane(tid >> 6), l31 = lane & 31, hh = lane >> 5;
    const bf16_t* XBC = (const bf16_t*)(P.ws + WS_XBC); bf16_t* ST = (bf16_t*)(P.ws + WS_ST); float* CD = (float*)(P.ws + WS_CD);
    LAS unsigned char* XWT = lds;
    LAS unsigned char* BT = lds + 256 * PITCH;
    LAS float* A1 = (LAS float*)(lds + 384 * PITCH); LAS float* A2 = A1 + 512; LAS float* A3 = A2 + 512; LAS float* A4 = A3 + 512;
    const int tok0 = b * SEQ + c * 128;
    __syncthreads();
    dt_tables(P, A1, A2, A3, A4, tok0, g);
    { float* TB = (float*)(P.ws + WS_DTT) + (size_t)((b * NCHUNK + c) * 2 + g) * 2048; *(f32x4*)(TB + tid * 4) = *(const LAS f32x4*)(A1 + tid * 4); }
    if (tid < 8) { const int r = tid & 3, dir = tid >> 2; CD[(size_t)((b * NCHUNK + c) * 2 + dir) * 8 + 4 * g + r] = fast_exp2(dir ? A2[r * 128] : A1[r * 128 + 127]); }
    bf16_t* XCX = (bf16_t*)(P.ws + WS_XCX); bf16_t* XCBC = (bf16_t*)(P.ws + WS_XCBC);
    u32x4 xo[2][8]; const float one8[8] = {1.f, 1.f, 1.f, 1.f, 1.f, 1.f, 1.f, 1.f};
#pragma unroll
    for (int it = 0; it < 2; ++it) { const int slot = it * 512 + tid, cg_ = slot & 63, run = slot >> 6;
        const int ch = cg_ < 32 ? g * 256 + 8 * cg_ : (cg_ < 48 ? 512 + g * 128 + 8 * (cg_ - 32) : 768 + g * 128 + 8 * (cg_ - 48));
        conv8x8(XBC, b, c * 128 + 8 * run, ch, P.conv_w, P.conv_b, xo[it]);
        bf16_t* gdst = cg_ < 32 ? XCX + (size_t)(tok0 + 8 * run) * 512 + (ch) : XCBC + (size_t)(tok0 + 8 * run) * 512 + (ch - 512);
#pragma unroll
        for (int tk = 0; tk < 8; ++tk) __builtin_nontemporal_store(xo[it][tk], (u32x4*)(gdst + (size_t)tk * 512));
        if (cg_ >= 32 && cg_ < 48) {
#pragma unroll
            for (int k = 0; k < 8; ++k) *(LAS u32x4*)(BT + (8 * (cg_ - 32) + k) * PITCH + 16 * run) = tr_chan<false>(xo[it], k, one8); } }
#pragma unroll 1
    for (int dir = 0; dir < 2; ++dir) {
        if (dir) __syncthreads();
#pragma unroll
        for (int it = 0; it < 2; ++it) { const int slot = it * 512 + tid, cg_ = slot & 63, run = slot >> 6;
            if (cg_ < 32) { const int r = cg_ >> 3; const float ref = dir ? A2[r * 128] : A1[r * 128 + 127]; const LAS float* qa = (dir ? A4 : A3) + r * 128 + 8 * run;
                float wg[8];
#pragma unroll
                for (int tk = 0; tk < 8; ++tk) wg[tk] = fast_exp2(ref - qa[tk]);
#pragma unroll
                for (int k = 0; k < 8; ++k) *(LAS u32x4*)(XWT + (8 * cg_ + k) * PITCH + 16 * run) = tr_chan<true>(xo[it], k, wg); } }
        __syncthreads();
        const int r = wid & 3, ph = wid >> 2;
        f32x16 acc[4];
#pragma unroll
        for (int nt = 0; nt < 4; ++nt)
#pragma unroll
            for (int q = 0; q < 16; ++q) acc[nt][q] = 0.f;
#pragma unroll
        for (int ks = 0; ks < 8; ++ks) {
            const bf16x8 af = *(const LAS bf16x8*)(XWT + (64 * r + 32 * ph + l31) * PITCH + (16 * ks + 8 * hh) * 2);
#pragma unroll
            for (int nt = 0; nt < 4; ++nt) { const bf16x8 bf = *(const LAS bf16x8*)(BT + (32 * nt + l31) * PITCH + (16 * ks + 8 * hh) * 2);
                acc[nt] = __builtin_amdgcn_mfma_f32_32x32x16_bf16(af, bf, acc[nt], 0, 0, 0); }
        }
        bf16_t* dst = ST + ((size_t)(((b * NCHUNK + c) * 2 + dir) * 8 + 4 * g + r)) * 8192 + (size_t)ph * 512;
        LAS unsigned char* stg = XWT + (64 * r + 32 * ph) * PITCH;
#pragma unroll
        for (int nt = 0; nt < 4; ++nt)
#pragma unroll
            for (int q = 0; q < 16; ++q) *(LAS bf16_t*)(stg + crow(q, hh) * PITCH + (32 * nt + l31) * 2) = (bf16_t)(pk_bf16(acc[nt][q], 0.f) & 0xffffu);
        LDS_WAIT();
#pragma unroll
        for (int i = 0; i < 8; ++i) { const int row = i * 4 + (lane >> 4), ck = lane & 15;
            *(u32x4*)(dst + (((ck >> 1) * 2) * 32 + row) * 16 + (ck & 1) * 8) = *(const LAS u32x4*)(stg + row * PITCH + ck * 16); }
    }
}

DEV void state_phase(LAS unsigned char* lds, const Params& P) {
    for (int u = blockIdx.x; u < NBATCH * NCHUNK * 2; u += gridDim.x) state_unit(lds, P, u >> 6, (u >> 1) & 31, u & 1);
    const int tid = opaque_tid(), lane = tid & 63, wave = tid >> 6, gw = blockIdx.x * 8 + wave, NGW = gridDim.x * 8;
    const bf16_t* Kg = (const bf16_t*)(P.ws + WS_K); unsigned* KMAX = (unsigned*)(P.ws + WS_CTL) + 64;
    for (int blk = gw; blk < NTOK / 32; blk += NGW) {
        float m = 0.f;
#pragma unroll 4
        for (int i = 0; i < 32; ++i) { const u32x4 v = *(const u32x4*)(Kg + (size_t)(blk * 32 + i) * 512 + lane * 8); float s = 0.f;
#pragma unroll
            for (int q = 0; q < 4; ++q) { const float a = bflo(v[q]), c = bfhi(v[q]); s += a * a + c * c; }
            s += xor_other<1>(s); s += xor_other<2>(s); s += xor_other<4>(s); m = fmaxf(m, s); }
        if ((lane & 7) == 0) atomicMax(&KMAX[((blk * 32) / SEQ) * 8 + (lane >> 3)], __float_as_uint(m));
    }
}

DEV void scan_phase(const Params& P) {
    bf16_t* ST = (bf16_t*)(P.ws + WS_ST); const float* CD = (const float*)(P.ws + WS_CD);
    const int gt = blockIdx.x * 512 + opaque_tid(), NGT = gridDim.x * 512;
    for (int item = gt; item < NBATCH * 2 * 8 * 64 * 16; item += NGT) {
        const int n8 = item & 15, p = (item >> 4) & 63, hd = (item >> 10) & 7, dir = (item >> 13) & 1, b = item >> 14;
        float acc[8];
#pragma unroll
        for (int k = 0; k < 8; ++k) acc[k] = 0.f;
        for (int s0 = 0; s0 < NCHUNK; s0 += 8) {
            u32x4 sv[8]; float dv[8];
#pragma unroll
            for (int j = 0; j < 8; ++j) { const int c = dir ? NCHUNK - 1 - (s0 + j) : s0 + j; const size_t ci = (size_t)((b * NCHUNK + c) * 2 + dir) * 8 + hd;
                sv[j] = *(const u32x4*)(ST + ci * 8192 + p * 128 + n8 * 8); dv[j] = CD[ci]; }
#pragma unroll
            for (int j = 0; j < 8; ++j) { const int c = dir ? NCHUNK - 1 - (s0 + j) : s0 + j; const size_t ci = (size_t)((b * NCHUNK + c) * 2 + dir) * 8 + hd;
                u32x4 w; w.x = pk_bf16(acc[0], acc[1]); w.y = pk_bf16(acc[2], acc[3]); w.z = pk_bf16(acc[4], acc[5]); w.w = pk_bf16(acc[6], acc[7]);
                __builtin_nontemporal_store(w, (u32x4*)(ST + ci * 8192 + p * 128 + n8 * 8));
#pragma unroll
                for (int q = 0; q < 4; ++q) { acc[2 * q] = dv[j] * acc[2 * q] + bflo(sv[j][q]); acc[2 * q + 1] = dv[j] * acc[2 * q + 1] + bfhi(sv[j][q]); } }
        }
    }
}

DEV void out_unit(LAS unsigned char* lds, const Params& P, int b, int c) {
    int tid_ = opaque_tid();
    const int tid = tid_, wid = __builtin_amdgcn_readfirstlane(tid >> 6);
    const bf16_t* XBC = (const bf16_t*)(P.ws + WS_XBC); const bf16_t* ST = (const bf16_t*)(P.ws + WS_ST); const bf16_t* Z = (const bf16_t*)(P.ws + WS_Z);
    bf16_t* MIX = (bf16_t*)(P.ws + WS_MIX); float* RLS = (float*)(P.ws + WS_RLS);
    LAS unsigned char* XT = lds;
    LAS unsigned char* BN = lds + 256 * PITCH;
    LAS unsigned char* CN = lds + 384 * PITCH;
    LAS float* A1 = (LAS float*)(lds + 512 * PITCH); LAS float* A2 = A1 + 512; LAS float* A3 = A2 + 512; LAS float* A4 = A3 + 512;
    LAS float* SSQ = A4 + 512;
    const int tok0 = b * SEQ + c * 128;
    for (int g = 0; g < 2; ++g) {
        unsigned pfh0, pfh1;
        { const unsigned char* hb0 = (const unsigned char*)(ST + ((size_t)(((b * NCHUNK + c) * 2 + 0) * 8 + 4 * g)) * 8192) + (size_t)tid * 128;
          pfh0 = *(const unsigned*)hb0; pfh1 = *(const unsigned*)(hb0 + (size_t)8 * 8192 * 2);
          pfh0 ^= *(const unsigned*)((const unsigned char*)(Z + (size_t)(tok0 + (tid >> 2)) * 512 + g * 256) + (tid & 3) * 128); }
        __syncthreads();
        { const float* TB = (const float*)(P.ws + WS_DTT) + (size_t)((b * NCHUNK + c) * 2 + g) * 2048; *(LAS f32x4*)(A1 + tid * 4) = *(const f32x4*)(TB + tid * 4); }
#pragma unroll 1
        for (int it = 0; it < 2; ++it) { int tc = tid; asm volatile("" : "+v"(tc)); const int slot = it * 512 + tc, cg_ = slot & 63, run = slot >> 6;
            const bf16_t* gsrc = cg_ < 32 ? (const bf16_t*)(P.ws + WS_XCX) + (size_t)(tok0 + 8 * run) * 512 + g * 256 + 8 * cg_
                                          : (const bf16_t*)(P.ws + WS_XCBC) + (size_t)(tok0 + 8 * run) * 512 + (cg_ < 48 ? g * 128 + 8 * (cg_ - 32) : 256 + g * 128 + 8 * (cg_ - 48));
            u32x4 xo[8]; const float one8[8] = {1.f, 1.f, 1.f, 1.f, 1.f, 1.f, 1.f, 1.f};
#pragma unroll
            for (int tk = 0; tk < 8; ++tk) xo[tk] = *(const u32x4*)(gsrc + (size_t)tk * 512);
            if (cg_ < 32) {
#pragma unroll
                for (int k = 0; k < 8; ++k) *(LAS u32x4*)(XT + (8 * cg_ + k) * PITCH + 16 * run) = tr_chan<false>(xo, k, one8);
            } else { LAS unsigned char* dst = (cg_ < 48 ? BN + 16 * (cg_ - 32) : CN + 16 * (cg_ - 48));
#pragma unroll
                for (int tk = 0; tk < 8; ++tk) *(LAS u32x4*)(dst + (8 * run + tk) * PITCH) = xo[tk]; } }
        asm volatile("" :: "v"(pfh0), "v"(pfh1));
        __syncthreads();
        int tq = tid; asm volatile("" : "+v"(tq));
        const int l31 = tq & 31, hh = (tq >> 5) & 1;
        const int li = wid & 3, hp = wid >> 2, l = 32 * li + l31;
        const LAS unsigned char* cfp = CN + l * PITCH + 16 * hh;
#pragma unroll 1
        for (int rr = 0; rr < 2; ++rr) {
            const int r = 2 * hp + rr, hd = 4 * g + r;
            const float af_l = A1[r * 128 + l], rb_l = A2[r * 128 + l], dskip = P.ssd_d[hd];
            const bf16_t* Hf = ST + ((size_t)(((b * NCHUNK + c) * 2 + 0) * 8 + hd)) * 8192 + l31 * 16 + 8 * hh;
            const bf16_t* Hb = Hf + (size_t)8 * 8192;
            bf16x8 hA[2][2], hB[2][2];
#define SSD_HLOAD(dst, src, k0) do { _Pragma("unroll") for (int ks = 0; ks < 2; ++ks) _Pragma("unroll") for (int mt = 0; mt < 2; ++mt) dst[ks][mt] = *(const bf16x8*)((src) + (((k0) + ks) * 2 + mt) * 512); } while (0)
#define SSD_HMMA(fr, k0, e) do { _Pragma("unroll") for (int ks = 0; ks < 2; ++ks) { const u32x4 cw = *(const LAS u32x4*)(cfp + 32 * ((k0) + ks)); \
                u32x4 ce; ce.x = pk_bf16(bflo(cw.x) * (e), bfhi(cw.x) * (e)); ce.y = pk_bf16(bflo(cw.y) * (e), bfhi(cw.y) * (e)); ce.z = pk_bf16(bflo(cw.z) * (e), bfhi(cw.z) * (e)); ce.w = pk_bf16(bflo(cw.w) * (e), bfhi(cw.w) * (e)); \
                const bf16x8 cfe = __builtin_bit_cast(bf16x8, ce); \
                _Pragma("unroll") for (int mt = 0; mt < 2; ++mt) yT[mt] = __builtin_amdgcn_mfma_f32_32x32x16_bf16(fr[ks][mt], cfe, yT[mt], 0, 0, 0); } } while (0)
            SSD_HLOAD(hA, Hf, 0);
            __builtin_amdgcn_sched_barrier(0);
            f32x16 cbt[4];
#pragma unroll
            for (int si = 0; si < 4; ++si)
#pragma unroll
                for (int q = 0; q < 16; ++q) cbt[si][q] = 0.f;
#pragma unroll
            for (int ks = 0; ks < 8; ++ks) {
                __builtin_amdgcn_sched_barrier(0);
                const bf16x8 cfk = *(const LAS bf16x8*)(cfp + 32 * ks);
#pragma unroll
                for (int si = 0; si < 4; ++si) { const bf16x8 bf = *(const LAS bf16x8*)(BN + (32 * si + l31) * PITCH + (16 * ks + 8 * hh) * 2);
                    cbt[si] = __builtin_amdgcn_mfma_f32_32x32x16_bf16(bf, cfk, cbt[si], 0, 0, 0); }
            }
            f32x16 yT[2];
#pragma unroll
            for (int mt = 0; mt < 2; ++mt)
#pragma unroll
                for (int q = 0; q < 16; ++q) yT[mt][q] = 0.f;
#pragma unroll
            for (int si = 0; si < 4; ++si) {
                __builtin_amdgcn_sched_barrier(0);
                f32x16 mv;
                if (si < li) {
#pragma unroll
                    for (int q4 = 0; q4 < 4; ++q4) { const f32x4 qf4 = *(const LAS f32x4*)(A3 + r * 128 + 32 * si + 8 * q4 + 4 * hh);
#pragma unroll
                        for (int e = 0; e < 4; ++e) mv[4 * q4 + e] = cbt[si][4 * q4 + e] * fast_exp2(af_l - qf4[e]); }
                } else if (si > li) {
#pragma unroll
                    for (int q4 = 0; q4 < 4; ++q4) { const f32x4 qb4 = *(const LAS f32x4*)(A4 + r * 128 + 32 * si + 8 * q4 + 4 * hh);
#pragma unroll
                        for (int e = 0; e < 4; ++e) mv[4 * q4 + e] = cbt[si][4 * q4 + e] * fast_exp2(rb_l - qb4[e]); }
                } else {
                    int lq = l; asm volatile("" : "+v"(lq));
#pragma unroll
                    for (int q4 = 0; q4 < 4; ++q4) { const int s0 = 32 * si + 8 * q4 + 4 * hh;
                        const f32x4 qf4 = *(const LAS f32x4*)(A3 + r * 128 + s0), qb4 = *(const LAS f32x4*)(A4 + r * 128 + s0);
                        __builtin_amdgcn_sched_barrier(0);
#pragma unroll
                        for (int e = 0; e < 4; ++e) { const int s = s0 + e;
                            const float gf = (s <= lq) ? fast_exp2(af_l - qf4[e]) : 0.f, gb = (s >= lq) ? fast_exp2(rb_l - qb4[e]) : 0.f;
                            mv[4 * q4 + e] = cbt[si][4 * q4 + e] * (gf + gb) + ((s == lq) ? dskip : 0.f); } }
                }
                bf16x8 mf[2];
#pragma unroll
                for (int s2 = 0; s2 < 2; ++s2) { u32x4 w; w.x = pk_bf16(mv[8 * s2 + 0], mv[8 * s2 + 1]); w.y = pk_bf16(mv[8 * s2 + 2], mv[8 * s2 + 3]); w.z = pk_bf16(mv[8 * s2 + 4], mv[8 * s2 + 5]); w.w = pk_bf16(mv[8 * s2 + 6], mv[8 * s2 + 7]); mf[s2] = __builtin_bit_cast(bf16x8, w); }
#pragma unroll
                for (int s2 = 0; s2 < 2; ++s2)
#pragma unroll
                    for (int mt = 0; mt < 2; ++mt) { const LAS unsigned char* xp = XT + (64 * r + 32 * mt + l31) * PITCH + (32 * si + 16 * s2 + 4 * hh) * 2;
                        const u32x2 xa = *(const LAS u32x2*)xp, xb = *(const LAS u32x2*)(xp + 16);
                        u32x4 xw; xw.x = xa.x; xw.y = xa.y; xw.z = xb.x; xw.w = xb.y;
                        yT[mt] = __builtin_amdgcn_mfma_f32_32x32x16_bf16(__builtin_bit_cast(bf16x8, xw), mf[s2], yT[mt], 0, 0, 0); }
            }
            { const float ef = fast_exp2(af_l), eb = fast_exp2(rb_l);
#define SSD_SB() __builtin_amdgcn_sched_barrier(0)
              bf16x8 hC[2][2], hD[2][2];
              SSD_SB(); SSD_HLOAD(hB, Hf, 2); SSD_HLOAD(hC, Hf, 4); SSD_HLOAD(hD, Hf, 6);
              SSD_SB(); SSD_HMMA(hA, 0, ef); SSD_SB();
              SSD_HLOAD(hA, Hb, 0); SSD_SB(); SSD_HMMA(hB, 2, ef); SSD_SB();
              SSD_HLOAD(hB, Hb, 2); SSD_SB(); SSD_HMMA(hC, 4, ef); SSD_SB();
              SSD_HLOAD(hC, Hb, 4); SSD_SB(); SSD_HMMA(hD, 6, ef); SSD_SB();
              SSD_HLOAD(hD, Hb, 6); SSD_SB(); SSD_HMMA(hA, 0, eb); SSD_SB();
              SSD_HMMA(hB, 2, eb); SSD_SB();
              SSD_HMMA(hC, 4, eb); SSD_SB();
              SSD_HMMA(hD, 6, eb); SSD_SB(); }
#undef SSD_SB
#undef SSD_HLOAD
#undef SSD_HMMA
            float ssq = 0.f;
            __builtin_amdgcn_sched_barrier(0);
#define SWAP32(a_, b_) do { const auto rr_ = __builtin_amdgcn_permlane32_swap((a_), (b_), false, false); (a_) = rr_[0]; (b_) = rr_[1]; } while (0)
#pragma unroll
            for (int mt = 0; mt < 2; ++mt)
#pragma unroll
                for (int j = 0; j < 2; ++j) { __builtin_amdgcn_sched_barrier(0); const int chb = g * 256 + 64 * r + 32 * mt + 16 * j;
                    u32x4 zl = *(const u32x4*)(Z + (size_t)(tok0 + l) * 512 + chb + 8 * hh);
                    SWAP32(zl.x, zl.z); SWAP32(zl.y, zl.w);
                    u32x2 w[2];
#pragma unroll
                    for (int o = 0; o < 2; ++o) { const int q4 = 2 * j + o; const f32x4 nw = *(const f32x4*)(P.ssd_norm_w + chb + 8 * o + 4 * hh);
                        const unsigned z0 = o ? zl.z : zl.x, z1 = o ? zl.w : zl.y;
                        const float g0 = yT[mt][4 * q4 + 0] * silu_f(bflo(z0)), g1 = yT[mt][4 * q4 + 1] * silu_f(bfhi(z0)), g2 = yT[mt][4 * q4 + 2] * silu_f(bflo(z1)), g3 = yT[mt][4 * q4 + 3] * silu_f(bfhi(z1));
                        ssq += (g0 * g0 + g1 * g1) + (g2 * g2 + g3 * g3);
                        w[o].x = pk_bf16(g0 * nw[0], g1 * nw[1]); w[o].y = pk_bf16(g2 * nw[2], g3 * nw[3]); }
                    SWAP32(w[0].x, w[1].x); SWAP32(w[0].y, w[1].y);
                    u32x4 ow; ow.x = w[0].x; ow.y = w[0].y; ow.z = w[1].x; ow.w = w[1].y;
                    *(u32x4*)(MIX + (size_t)(tok0 + l) * DM + chb + 8 * hh) = ow; }
#undef SWAP32
            SSQ[l * 16 + hd * 2 + hh] = ssq;
        }
    }
    __syncthreads();
    if (tid < 128) { float s = 0.f;
#pragma unroll
        for (int j = 0; j < 16; ++j) s += SSQ[tid * 16 + j];
        RLS[tok0 + tid] = rsqrtf(s * (1.f / 512.f) + EPS); }
}
DEV void out_phase(LAS unsigned char* lds, const Params& P) {
    for (int u = blockIdx.x; u < NBATCH * NCHUNK; u += gridDim.x) out_unit(lds, P, u >> 5, u & 31);
}
}

DEV void route_phase(LAS unsigned char* lds, const Params& P) {
    const int tid = opaque_tid();
    LAS unsigned* hist = (LAS unsigned*)(lds); LAS unsigned* base = hist + 32;
    const float* LOG = (const float*)(P.ws + WS_LOG); const float* RSS = (const float*)(P.ws + WS_RSS);
    unsigned* cnt = (unsigned*)(P.ws + WS_CTL);
    int* LTOK = (int*)(P.ws + WS_LTOK); float* LGATE = (float*)(P.ws + WS_LGATE); float* LRL = (float*)(P.ws + WS_LRL); unsigned* TOKEP = (unsigned*)(P.ws + WS_TOKEP);
    for (int tb = blockIdx.x; tb < NTOK / 512; tb += gridDim.x) {
        __syncthreads();
        if (tid < 32) hist[tid] = 0u;
        __syncthreads();
        const int t = tb * 512 + tid;
        float ss = 0.f;
#pragma unroll
        for (int j = 0; j < 4; ++j) { const f32x4 v = *(const f32x4*)(RSS + (size_t)t * 16 + 4 * j); ss += (v[0] + v[1]) + (v[2] + v[3]); }
        const float r = rsqrtf(ss * (1.f / DM) + EPS);
        const f32x4 gl4 = *(const f32x4*)(LOG + (size_t)t * 64);
        float gl[4];
#pragma unroll
        for (int j = 0; j < 4; ++j) gl[j] = gl4[j] * r + P.b_rg[j];
        int g = 0; float gm = gl[0];
#pragma unroll
        for (int j = 1; j < 4; ++j) if (gl[j] > gm) { gm = gl[j]; g = j; }
        float gs = 0.f;
#pragma unroll
        for (int j = 0; j < 4; ++j) gs += expf(gl[j] - gm);
        const float pg = 1.f / gs;
        const f32x4 e0 = *(const f32x4*)(LOG + (size_t)t * 64 + 4 + 8 * g), e1 = *(const f32x4*)(LOG + (size_t)t * 64 + 8 + 8 * g);
        const f32x4 b0 = *(const f32x4*)(P.b_re + 8 * g), b1 = *(const f32x4*)(P.b_re + 8 * g + 4);
        float el[8];
#pragma unroll
        for (int j = 0; j < 4; ++j) { el[j] = e0[j] * r + b0[j]; el[4 + j] = e1[j] * r + b1[j]; }
        int i1 = 0; float m1 = el[0];
#pragma unroll
        for (int j = 1; j < 8; ++j) if (el[j] > m1) { m1 = el[j]; i1 = j; }
        int i2 = -1; float m2 = -INFINITY;
#pragma unroll
        for (int j = 0; j < 8; ++j) if (j != i1 && el[j] > m2) { m2 = el[j]; i2 = j; }
        const float w1 = 1.f / (1.f + expf(m2 - m1)), w2 = 1.f - w1;
        const int ex1 = 8 * g + i1, ex2 = 8 * g + i2;
        const unsigned k1 = __hip_atomic_fetch_add(&hist[ex1], 1u, __ATOMIC_RELAXED, __HIP_MEMORY_SCOPE_WORKGROUP), k2 = __hip_atomic_fetch_add(&hist[ex2], 1u, __ATOMIC_RELAXED, __HIP_MEMORY_SCOPE_WORKGROUP);
        __syncthreads();
        if (tid < 32) base[tid] = atomicAdd(&cnt[tid], hist[tid]);
        __syncthreads();
        const unsigned p1 = base[ex1] + k1, p2 = base[ex2] + k2;
        LTOK[(size_t)ex1 * 65536 + p1] = t; LGATE[(size_t)ex1 * 65536 + p1] = pg * w1; LRL[(size_t)ex1 * 65536 + p1] = r;
        LTOK[(size_t)ex2 * 65536 + p2] = t; LGATE[(size_t)ex2 * 65536 + p2] = pg * w2; LRL[(size_t)ex2 * 65536 + p2] = r;
        TOKEP[(size_t)t * 2] = ((unsigned)ex1 << 16) | p1; TOKEP[(size_t)t * 2 + 1] = ((unsigned)ex2 << 16) | p2;
    }
}

DEV void moe_tables(LAS unsigned char* lds, const Params& P) {
    LAS int* T = (LAS int*)(lds + LDS_MISC);
    const unsigned* cnt = (const unsigned*)(P.ws + WS_CTL);
    __syncthreads();
    if (opaque_tid() == 0) { int ts = 0, ps = 0;
        for (int e = 0; e < 32; ++e) { const int c = (int)__hip_atomic_load(cnt + e, __ATOMIC_RELAXED, __HIP_MEMORY_SCOPE_AGENT); const int nt = (c + 255) >> 8;
            T[e] = c; T[32 + e] = ts; T[65 + e] = ps; ts += nt; ps += nt * 256; }
        T[64] = ts; T[97] = ps; }
    __syncthreads();
}

DEV void final_phase(LAS unsigned char* lds, const Params& P) {
    const int tid = opaque_tid(), lane = tid & 63, wave = tid >> 6, gw = blockIdx.x * 8 + wave, NGW = gridDim.x * 8;
    const bf16_t* H = (const bf16_t*)(P.ws + WS_H); const bf16_t* Y = (const bf16_t*)(P.ws + WS_Y); const unsigned* TOKEP = (const unsigned*)(P.ws + WS_TOKEP);
    const LAS int* pstart = (const LAS int*)(lds + LDS_MISC) + 65;
    f32x4 wv[2][2];
#pragma unroll
    for (int j = 0; j < 2; ++j) { wv[j][0] = *(const f32x4*)(P.norm_final_w + 8 * (lane + 64 * j)); wv[j][1] = *(const f32x4*)(P.norm_final_w + 8 * (lane + 64 * j) + 4); }
#define FIN_TOK(ep, t) ep = *(const u32x2*)(TOKEP + (size_t)(t) * 2)
#define FIN_LOAD(hv, yv, ep, t) do { _Pragma("unroll") for (int j = 0; j < 2; ++j) hv[j] = *(const u32x4*)(H + (size_t)(t) * DM + 8 * (lane + 64 * j)); \
        _Pragma("unroll") for (int k = 0; k < 2; ++k) { const unsigned e_ = (k ? ep.y : ep.x); const size_t slot = (size_t)pstart[e_ >> 16] + (e_ & 0xffffu); \
            _Pragma("unroll") for (int j = 0; j < 2; ++j) yv[k][j] = __builtin_nontemporal_load((const u32x4*)(Y + slot * 1024 + 8 * (lane + 64 * j))); } } while (0)
#define FIN_EMIT(hv, yv, t) do { float v[2][8]; \
        _Pragma("unroll") for (int j = 0; j < 2; ++j) _Pragma("unroll") for (int q = 0; q < 4; ++q) { \
            v[j][2 * q] = (bflo(hv[j][q]) + bflo(yv[0][j][q])) + bflo(yv[1][j][q]); v[j][2 * q + 1] = (bfhi(hv[j][q]) + bfhi(yv[0][j][q])) + bfhi(yv[1][j][q]); } \
        float s_ = 0.f; \
        _Pragma("unroll") for (int j = 0; j < 2; ++j) _Pragma("unroll") for (int q = 0; q < 8; ++q) s_ += v[j][q] * v[j][q]; \
        const float r = rsqrtf(wave_sum(s_) * (1.f / DM) + EPS); \
        _Pragma("unroll") for (int j = 0; j < 2; ++j) { float* o = P.out + (size_t)(t) * DM + 8 * (lane + 64 * j); \
            f32x4 a, c; a[0] = v[j][0] * r * wv[j][0][0]; a[1] = v[j][1] * r * wv[j][0][1]; a[2] = v[j][2] * r * wv[j][0][2]; a[3] = v[j][3] * r * wv[j][0][3]; \
            c[0] = v[j][4] * r * wv[j][1][0]; c[1] = v[j][5] * r * wv[j][1][1]; c[2] = v[j][6] * r * wv[j][1][2]; c[3] = v[j][7] * r * wv[j][1][3]; \
            __builtin_nontemporal_store(a, (f32x4*)o); __builtin_nontemporal_store(c, (f32x4*)(o + 4)); } } while (0)
    u32x2 epA = {0u, 0u}, epB = {0u, 0u}; u32x4 hA[2], hB[2], yA[2][2], yB[2][2];
    int t = gw;
    if (t < NTOK) FIN_TOK(epA, t);
    if (t + NGW < NTOK) FIN_TOK(epB, t + NGW);
    if (t < NTOK) FIN_LOAD(hA, yA, epA, t);
    while (t < NTOK) {
        const int t1 = t + NGW, t2 = t1 + NGW, t3 = t2 + NGW;
        if (t2 < NTOK) FIN_TOK(epA, t2);
        if (t1 < NTOK) FIN_LOAD(hB, yB, epB, t1);
        FIN_EMIT(hA, yA, t);
        if (t1 >= NTOK) break;
        if (t3 < NTOK) FIN_TOK(epB, t3);
        if (t2 < NTOK) FIN_LOAD(hA, yA, epA, t2);
        FIN_EMIT(hB, yB, t1);
        t = t2;
    }
#undef FIN_TOK
#undef FIN_LOAD
#undef FIN_EMIT
}


#define XB_TMO      128
#define XB_XCNT(j)  (256  + 64 * (j))
#define XB_XSUB(j)  (1280 + 64 * (j))
#define XB_XGEN(j)  (2304 + 64 * (j))
#define XB_TOP      3328
#define XB_TOPGEN   3392
#define XCD_BAR_WORDS 3456
#define XB_SPIN_CAP (1u << 18)

__device__ __forceinline__ unsigned xb_ld(unsigned* p)              { return __hip_atomic_load(p, __ATOMIC_RELAXED, __HIP_MEMORY_SCOPE_AGENT); }
__device__ __forceinline__ unsigned xb_add(unsigned* p, unsigned v) { return __hip_atomic_fetch_add(p, v, __ATOMIC_RELAXED, __HIP_MEMORY_SCOPE_AGENT); }
__device__ __forceinline__ unsigned xb_xcc_id() { return (unsigned)__builtin_amdgcn_s_getreg((3 << 11) | 20) & 0xFu; }
#define XB_SPIN(cond, bar) do { unsigned _sp = 0; while (cond) { __builtin_amdgcn_s_sleep(1); \
    if ((++_sp & 255u) == 0u) { if (xb_ld(&(bar)[XB_TMO])) break; if (_sp > XB_SPIN_CAP) { atomicAdd(&(bar)[XB_TMO], 1u); break; } } } } while (0)

struct XcdBarrier {
    unsigned* bar; unsigned x;
    volatile LAS unsigned* st;
};

__device__ __forceinline__ XcdBarrier xcd_barrier_post(unsigned* bar, volatile LAS unsigned* st) {
    XcdBarrier b; b.bar = bar; b.x = xb_xcc_id(); b.st = st;
    if (opaque_tid() == 0) (void)xb_add(&bar[XB_XCNT(b.x)], 1u);
    return b;
}
__device__ __forceinline__ void xcd_barrier_complete(unsigned* bar, unsigned x, unsigned& nloc, unsigned& nx) {
    const unsigned G = gridDim.x * gridDim.y * gridDim.z;
    unsigned sum, cnt, mine, sp = 0u;
    for (;;) {
        sum = 0u; cnt = 0u; mine = 0u;
#pragma unroll
        for (unsigned j = 0; j < 16; ++j) { const unsigned c = xb_ld(&bar[XB_XCNT(j)]); sum += c; cnt += (c > 0u) ? 1u : 0u; mine = (j == x) ? c : mine; }
        if (sum == G) break;
        __builtin_amdgcn_s_sleep(1);
        if ((++sp & 255u) == 0u) { if (xb_ld(&bar[XB_TMO])) break; if (sp > XB_SPIN_CAP) { atomicAdd(&bar[XB_TMO], 1u); break; } }
    }
    nloc = mine > 0u ? mine : 1u; nx = cnt > 0u ? cnt : 1u;
}

__device__ __forceinline__ void xcd_barrier(const XcdBarrier& b) {
    asm volatile("s_waitcnt vmcnt(0)" ::: "memory");
    __syncthreads();
    if (opaque_tid() == 0) {
        unsigned* bar = b.bar;
        __builtin_amdgcn_s_waitcnt(0);
        unsigned nloc = b.st[0], nx = b.st[1];
        if (nloc == 0u) { xcd_barrier_complete(bar, b.x, nloc, nx); b.st[0] = nloc; b.st[1] = nx; }
        const unsigned old = xb_add(&bar[XB_XSUB(b.x)], 1u);
        const unsigned gen = old / nloc;
        if (old + 1u == (gen + 1u) * nloc) {
            __builtin_amdgcn_fence(__ATOMIC_RELEASE, "agent");
            asm volatile("s_waitcnt vmcnt(0)" ::: "memory");
            const unsigned og = xb_add(&bar[XB_TOP], 1u);
            const unsigned tg = og / nx;
            if (og + 1u == (tg + 1u) * nx) xb_add(&bar[XB_TOPGEN], 1u);
            else XB_SPIN(xb_ld(&bar[XB_TOPGEN]) == tg, bar);
            __builtin_amdgcn_fence(__ATOMIC_ACQUIRE, "agent");
            xb_add(&bar[XB_XGEN(b.x)], 1u);
            asm volatile("s_waitcnt vmcnt(0)" ::: "memory");
        } else {
            XB_SPIN(xb_ld(&bar[XB_XGEN(b.x)]) == gen, bar);
            __builtin_amdgcn_fence(__ATOMIC_ACQUIRE, "agent");
            asm volatile("s_waitcnt vmcnt(0)" ::: "memory");
        }
    }
    __syncthreads();
}


DEV Params load_params() {
    const __attribute__((address_space(4))) Params* p = (const __attribute__((address_space(4))) Params*)__builtin_amdgcn_kernarg_segment_ptr();
    asm volatile("" : "+s"(p));
    Params r;
    r.x = p->x;
    r.norm_mix_w = p->norm_mix_w;
    r.w_in = p->w_in;
    r.conv_w = p->conv_w;
    r.conv_b = p->conv_b;
    r.dt_bias_f = p->dt_bias_f;
    r.dt_bias_b = p->dt_bias_b;
    r.a_log_f = p->a_log_f;
    r.a_log_b = p->a_log_b;
    r.ssd_d = p->ssd_d;
    r.ssd_norm_w = p->ssd_norm_w;
    r.lq1 = p->lq1;
    r.lk1 = p->lk1;
    r.lq2 = p->lq2;
    r.lk2 = p->lk2;
    r.subln_w = p->subln_w;
    r.w_out = p->w_out;
    r.norm_ffn_w = p->norm_ffn_w;
    r.w_rg = p->w_rg;
    r.b_rg = p->b_rg;
    r.w_re = p->w_re;
    r.b_re = p->b_re;
    r.w_gate = p->w_gate;
    r.w_up = p->w_up;
    r.w_down = p->w_down;
    r.norm_final_w = p->norm_final_w;
    r.out = p->out;
    r.ws = p->ws;
    return r;
}

__global__ void __launch_bounds__(512, 2) hymba_fwd(Params Pk) {
    extern __shared__ __attribute__((aligned(16))) unsigned char lds_raw[];
    LAS unsigned char* lds = (LAS unsigned char*)lds_raw;
    cg::grid_group grid = cg::this_grid();
    const int G = gridDim.x, c = blockIdx.x;
    { volatile LAS unsigned* st = (volatile LAS unsigned*)(lds + LDS_BYTES - 16);
      if (threadIdx.x < 4) st[threadIdx.x] = 0u;
      if ((threadIdx.x & 63) == 0) *(LAS int*)(lds + LDS_WTAB + 4 * hw_wave_slot()) = (int)(threadIdx.x >> 6);
      __syncthreads(); }
    XcdBarrier xbar;
    { const Params P = load_params();
      if (P.ws == nullptr) grid.sync();
      xbar = xcd_barrier_post((unsigned*)(P.ws + WS_CTL) + 1024, (volatile LAS unsigned*)(lds + LDS_BYTES - 16)); }
#define GRID_SYNC() xcd_barrier(xbar)

    { const Params P = load_params(); p0_phase(P, lds); }
    GRID_SYNC();
    { const Params P = load_params();
      g8::SchedInProj S{(const char*)(P.ws + WS_U), (const char*)(P.ws + WS_WIN), G, c};
      g8::EpiInProj E{(bf16_t*)(P.ws + WS_Z), (bf16_t*)(P.ws + WS_XBC), (bf16_t*)(P.ws + WS_Q), (bf16_t*)(P.ws + WS_K), (bf16_t*)(P.ws + WS_VT), (float*)(P.ws + WS_DT)};
      g8::gemm_phase(lds, 1024, S, E); }
    GRID_SYNC();
    { const Params P = load_params(); ssd::state_phase(lds, P); }
    GRID_SYNC();
    { const Params P = load_params(); ssd::scan_phase(P); }
    GRID_SYNC();
    { const Params P = load_params(); att::attn_phase(lds, P); }
    { const Params P = load_params(); ssd::out_phase(lds, P); }
    GRID_SYNC();
    { const Params P = load_params();
      g8::SchedOutProj S{(const char*)(P.ws + WS_MIX), (const char*)(P.ws + WS_WOUT), (const float*)(P.ws + WS_RLS), G, c};
      g8::EpiOutProj E{P.x, (bf16_t*)(P.ws + WS_H), (float*)(P.ws + WS_RSS)};
      g8::gemm_phase(lds, 1024, S, E); }
    GRID_SYNC();
    { const Params P = load_params();
      g8::SchedRouter S{(const char*)(P.ws + WS_H), (const char*)(P.ws + WS_WR), G, c};
      g8::EpiRouter E{(float*)(P.ws + WS_LOG)};
      g8::gemm_phase(lds, 1024, S, E); }
    GRID_SYNC();
    { const Params P = load_params(); route_phase(lds, P); }
    GRID_SYNC();
    { const Params P = load_params(); moe_tables(lds, P); }
    { const Params P = load_params();
      const LAS int* T = (const LAS int*)(lds + LDS_MISC);
      g8::MoeTables MT{T, T + 32, T + 65};
      g8::SchedMoe1 S{(const char*)(P.ws + WS_H), (const char*)(P.ws + WS_WGU), (const int*)(P.ws + WS_LTOK), MT, G, c};
      g8::EpiMoe1 E{(bf16_t*)(P.ws + WS_HDN), (const float*)(P.ws + WS_LRL), (const float*)(P.ws + WS_LGATE)};
      g8::gemm_phase(lds, 1024, S, E);
      GRID_SYNC(); }
    { const Params P = load_params();
      const LAS int* T = (const LAS int*)(lds + LDS_MISC);
      g8::MoeTables MT{T, T + 32, T + 65};
      g8::SchedMoe2 S2{(const char*)(P.ws + WS_HDN), (const char*)(P.ws + WS_WD), MT, G, c};
      g8::EpiMoe2 E2{(bf16_t*)(P.ws + WS_Y)};
      g8::gemm_phase(lds, 512, S2, E2); }
    GRID_SYNC();
    { const Params P = load_params(); final_phase(lds, P); }
}

extern "C" void kernel_launch(void* const* d_in, const int* in_sizes, int n_in, void* d_out, int out_size, void* d_ws, size_t ws_size, hipStream_t stream) {
    static int grid = 0;
    if (grid == 0) {
        if (n_in != 26 || out_size != NTOK * DM || ws_size < WS_END) { fprintf(stderr, "kernel_launch: unexpected problem (n_in %d, out %d, ws %zu); nothing launched\n", n_in, out_size, ws_size); grid = -1; return; }
        int dev = 0, cus = 0, per_cu = 0;
        hipGetDevice(&dev); hipDeviceGetAttribute(&cus, hipDeviceAttributeMultiprocessorCount, dev);
        if (hipFuncSetAttribute((const void*)hymba_fwd, hipFuncAttributeMaxDynamicSharedMemorySize, LDS_BYTES) != hipSuccess) { fprintf(stderr, "kernel_launch: hipFuncSetAttribute failed\n"); grid = -1; return; }
        if (hipOccupancyMaxActiveBlocksPerMultiprocessor(&per_cu, (const void*)hymba_fwd, 512, LDS_BYTES) != hipSuccess || per_cu < 1) { fprintf(stderr, "kernel_launch: occupancy query says %d blocks per CU\n", per_cu); grid = -1; (void)hipGetLastError(); return; }
        grid = cus;
    }
    if (grid < 0) return;
    hipMemsetAsync((char*)d_ws + WS_CTL, 0, CTL_ZERO_BYTES, stream);
    Params p{};
    const float** pp = (const float**)&p;
    for (int i = 0; i < 26; ++i) pp[i] = (const float*)d_in[i];
    p.out = (float*)d_out; p.ws = (unsigned char*)d_ws;
    void* args[] = {&p};
    hipError_t e = hipLaunchCooperativeKernel((const void*)hymba_fwd, dim3(grid), dim3(512), args, LDS_BYTES, stream);
    if (e != hipSuccess) fprintf(stderr, "kernel_launch: cooperative launch failed: %s (grid %d)\n", hipGetErrorString(e), grid);
}
```
